# Optimizing an MI355X kernel written in HIP

```python
import math
import jax, jax.numpy as jnp
from jax import lax
import numpy as np

D_MODEL = 1024
BATCH = 16
SEQ = 2048
DEPTH = 1
DEC_BATCH = 128
DEC_SEQ = 8
PAST_LEN = 16384
PAGE_SIZE = 128

D_MIX = D_MODEL
D_ATT = D_MIX // 2
D_RET = D_MIX - D_ATT
HEAD_DIM_A = 64
N_HEADS_A = D_ATT // HEAD_DIM_A
N_KV_HEADS_A = 2
GROUP_A = N_HEADS_A // N_KV_HEADS_A
KV_W = N_KV_HEADS_A * HEAD_DIM_A
WINDOW = 128
BLOCK_A = WINDOW
N_HEADS_R = 4
HEAD_DIM_R = D_RET // N_HEADS_R
CHUNK_R = 128
ROPE_BASE = 10000.0
LN_EPS = 1e-5
GN_EPS = 1e-5
DEEPNORM_ALPHA = float((2 * DEPTH) ** 0.25)
DEEPNORM_BETA = float((8 * DEPTH) ** -0.25)
SPLIT_SIZES = (D_ATT, KV_W, KV_W, D_ATT, D_RET, D_RET, D_RET, D_RET)
D_IN = sum(SPLIT_SIZES)
SPLIT_POINTS = [int(s) for s in np.cumsum(SPLIT_SIZES)[:-1]]

kernel_name = "hymba_swa_sink_retention_deepnorm_adaln_step"


def _front(x, c, w_ada, b_ada, w_in):
    B, T, _ = x.shape
    cond = jax.nn.silu(c) @ w_ada + b_ada
    shift, scale, gate = jnp.split(cond, 3, axis=-1)
    h = x * (1.0 + scale[:, None, :]) + shift[:, None, :]
    z = h @ w_in
    q_a, k_a, v_a, g_a, q_r, k_r, v_r, g_r = jnp.split(z, SPLIT_POINTS, axis=-1)
    q_a = q_a.reshape(B, T, N_KV_HEADS_A, GROUP_A, HEAD_DIM_A)
    k_a = k_a.reshape(B, T, N_KV_HEADS_A, HEAD_DIM_A)
    v_a = v_a.reshape(B, T, N_KV_HEADS_A, HEAD_DIM_A)
    q_r = q_r.reshape(B, T, N_HEADS_R, HEAD_DIM_R)
    k_r = k_r.reshape(B, T, N_HEADS_R, HEAD_DIM_R)
    v_r = v_r.reshape(B, T, N_HEADS_R, HEAD_DIM_R)
    return (q_a, k_a, v_a, g_a, q_r, k_r, v_r, g_r), gate


def _back(x, gate, o_a, g_a, o_r, g_r, gn_w, w_out, ln_w, ln_b):
    B, T, _ = x.shape
    o_r = o_r.astype(jnp.float32)
    mu = o_r.mean(-1, keepdims=True)
    var = jnp.square(o_r - mu).mean(-1, keepdims=True)
    o_r = ((o_r - mu) * lax.rsqrt(var + GN_EPS)).reshape(B, T, D_RET).astype(x.dtype) * gn_w
    o_a = o_a.reshape(B, T, D_ATT).astype(x.dtype)
    mixed = jnp.concatenate([o_a * jax.nn.silu(g_a), o_r * jax.nn.silu(g_r)], axis=-1)
    y = mixed @ w_out
    r = (DEEPNORM_ALPHA * x + gate[:, None, :] * y).astype(jnp.float32)
    mu = r.mean(-1, keepdims=True)
    var = jnp.square(r - mu).mean(-1, keepdims=True)
    rn = (r - mu) * lax.rsqrt(var + LN_EPS)
    return (rn * ln_w + ln_b).astype(x.dtype)


def _rotary(x, pos):
    half = x.shape[-1] // 2
    inv = ROPE_BASE ** (-jnp.arange(half, dtype=jnp.float32) / half)
    ang = pos[:, None] * inv[None, :]
    cos = jnp.cos(ang)[:, None, :]
    sin = jnp.sin(ang)[:, None, :]
    xf = x.astype(jnp.float32)
    x1, x2 = xf[..., :half], xf[..., half:]
    return jnp.concatenate([x1 * cos - x2 * sin, x2 * cos + x1 * sin], axis=-1).astype(x.dtype)


def _sink_attention(q, k, v, qpos, kpos, sinks):
    s = jnp.einsum('bnqhgd,bnkhd->bnhgqk', q, k).astype(jnp.float32) * (HEAD_DIM_A ** -0.5)
    rel = qpos[:, :, None] - kpos[:, None, :]
    valid = (rel >= 0) & (rel <= WINDOW) & (kpos[:, None, :] >= 0)
    s = jnp.where(valid[None, :, None, None], s, -1e30)
    sink = sinks.astype(jnp.float32).reshape(1, 1, N_KV_HEADS_A, GROUP_A, 1, 1)
    m = jnp.maximum(s.max(-1, keepdims=True), sink)
    p = jnp.exp(s - m)
    p = p / (p.sum(-1, keepdims=True) + jnp.exp(sink - m))
    return jnp.einsum('bnhgqk,bnkhd->bnqhgd', p.astype(v.dtype), v)


def _swa_prompt(q, k, v, sinks):
    B, T = q.shape[0], q.shape[1]
    nb = T // BLOCK_A
    qb = q.reshape(B, nb, BLOCK_A, N_KV_HEADS_A, GROUP_A, HEAD_DIM_A)
    kb = k.reshape(B, nb, BLOCK_A, N_KV_HEADS_A, HEAD_DIM_A)
    vb = v.reshape(B, nb, BLOCK_A, N_KV_HEADS_A, HEAD_DIM_A)
    kk = jnp.concatenate([jnp.concatenate([jnp.zeros_like(kb[:, :1]), kb[:, :-1]], axis=1), kb], axis=2)
    vv = jnp.concatenate([jnp.concatenate([jnp.zeros_like(vb[:, :1]), vb[:, :-1]], axis=1), vb], axis=2)
    start = jnp.arange(nb)[:, None] * BLOCK_A
    qpos = start + jnp.arange(BLOCK_A)[None, :]
    kpos = start - BLOCK_A + jnp.arange(2 * BLOCK_A)[None, :]
    o = _sink_attention(qb, kk, vv, qpos, kpos, sinks)
    return o.reshape(B, T, N_KV_HEADS_A, GROUP_A, HEAD_DIM_A)


def _swa_sample(q, k, v, cache_k, cache_v, sinks):
    keys = jnp.concatenate([cache_k.astype(k.dtype), k], axis=1)
    vals = jnp.concatenate([cache_v.astype(v.dtype), v], axis=1)
    T = q.shape[1]
    qpos = (PAST_LEN + jnp.arange(T))[None, :]
    kpos = (PAST_LEN - WINDOW + jnp.arange(WINDOW + T))[None, :]
    o = _sink_attention(q[:, None], keys[:, None], vals[:, None], qpos, kpos, sinks)[:, 0]
    return o, keys[:, -WINDOW:], vals[:, -WINDOW:]


def _retention_chunk(q, k, v, S, log_gamma):
    L = q.shape[1]
    idx = jnp.arange(L, dtype=jnp.float32)
    diff = idx[:, None] - idx[None, :]
    dmat = jnp.where(diff >= 0, jnp.exp(log_gamma[:, None, None] * jnp.maximum(diff, 0.0)), 0.0)
    qf, kf, vf, Sf = (a.astype(jnp.float32) for a in (q, k, v, S))
    s = jnp.einsum('bihd,bjhd->bhij', qf, kf) * dmat[None]
    intra = jnp.einsum('bhij,bjhe->bihe', s, vf)
    q_decay = jnp.exp(log_gamma[None, :] * (idx[:, None] + 1.0))
    inter = jnp.einsum('bihd,bhde->bihe', qf, Sf) * q_decay[None, :, :, None]
    k_decay = jnp.exp(log_gamma[None, :] * (L - 1.0 - idx[:, None]))
    S_new = jnp.exp(log_gamma * L)[None, :, None, None] * Sf + jnp.einsum(
        'bjhd,bjhe->bhde', kf * k_decay[None, :, :, None], vf)
    return intra + inter, S_new


def _retention_prompt(q, k, v, log_gamma):
    B, T = q.shape[0], q.shape[1]
    nc = T // CHUNK_R

    def to_chunks(a):
        return jnp.moveaxis(a.reshape(B, nc, CHUNK_R, N_HEADS_R, HEAD_DIM_R), 1, 0)

    def step(S, qkv):
        qc, kc, vc = qkv
        o, S = _retention_chunk(qc, kc, vc, S, log_gamma)
        return S, o

    S0 = jnp.zeros((B, N_HEADS_R, HEAD_DIM_R, HEAD_DIM_R), jnp.float32)
    S, o = lax.scan(step, S0, (to_chunks(q), to_chunks(k), to_chunks(v)))
    o = jnp.moveaxis(o, 0, 1).reshape(B, T, N_HEADS_R, HEAD_DIM_R)
    return o, S


def setup_inputs(seed: int = 0) -> dict:
    key = jax.random.key(seed)
    ks = jax.random.split(key, 16)
    nrm = jax.random.normal
    f32 = jnp.float32
    return {
        "x_prompt": nrm(ks[0], (BATCH, SEQ, D_MODEL), f32),
        "x_sample": nrm(ks[1], (DEC_BATCH, DEC_SEQ, D_MODEL), f32),
        "c_prompt": nrm(ks[2], (BATCH, D_MODEL), f32),
        "c_sample": nrm(ks[3], (DEC_BATCH, D_MODEL), f32),
        "cache_k_win": nrm(ks[4], (DEPTH, DEC_BATCH, WINDOW, N_KV_HEADS_A, HEAD_DIM_A), f32),
        "cache_v_win": nrm(ks[5], (DEPTH, DEC_BATCH, WINDOW, N_KV_HEADS_A, HEAD_DIM_A), f32),
        "state_ret": 0.5 * nrm(ks[6], (DEPTH, DEC_BATCH, N_HEADS_R, HEAD_DIM_R, HEAD_DIM_R), f32),
        "w_ada": 0.5 * D_MODEL ** -0.5 * nrm(ks[7], (DEPTH, D_MODEL, 3 * D_MODEL), f32),
        "b_ada": 0.02 * nrm(ks[8], (DEPTH, 3 * D_MODEL), f32),
        "w_in": D_MODEL ** -0.5 * nrm(ks[9], (DEPTH, D_MODEL, D_IN), f32),
        "attn_sinks": 0.5 * nrm(ks[10], (DEPTH, N_HEADS_A), f32),
        "ret_gn_w": 1.0 + 0.02 * nrm(ks[11], (DEPTH, D_RET), f32),
        "w_out": DEEPNORM_BETA * D_MIX ** -0.5 * nrm(ks[12], (DEPTH, D_MIX, D_MODEL), f32),
        "ln_w": 1.0 + 0.02 * nrm(ks[13], (DEPTH, D_MODEL), f32),
        "ln_b": 0.02 * nrm(ks[14], (DEPTH, D_MODEL), f32),
    }


def reference(x_prompt, x_sample, c_prompt, c_sample, cache_k_win, cache_v_win, state_ret,
              w_ada, b_ada, w_in, attn_sinks, ret_gn_w, w_out, ln_w, ln_b):
    log_gamma = jnp.log(1.0 - 2.0 ** (-5.0 - jnp.arange(N_HEADS_R, dtype=jnp.float32)))
    pos_p = jnp.arange(x_prompt.shape[1], dtype=jnp.float32)
    pos_s = (PAST_LEN + jnp.arange(x_sample.shape[1])).astype(jnp.float32)
    x_p, x_s = x_prompt, x_sample
    kp_l, vp_l, sp_l, ks_l, vs_l, ss_l = [], [], [], [], [], []
    for l in range(DEPTH):
        (q_a, k_a, v_a, g_a, q_r, k_r, v_r, g_r), gate = _front(x_p, c_prompt, w_ada[l], b_ada[l], w_in[l])
        o_a = _swa_prompt(q_a, k_a, v_a, attn_sinks[l])
        q_r = _rotary(q_r, pos_p)
        k_r = _rotary(k_r, pos_p) * (HEAD_DIM_R ** -0.5)
        o_r, S_p = _retention_prompt(q_r, k_r, v_r, log_gamma)
        kp_l.append(k_a[:, -WINDOW:])
        vp_l.append(v_a[:, -WINDOW:])
        sp_l.append(S_p)
        x_p = _back(x_p, gate, o_a, g_a, o_r, g_r, ret_gn_w[l], w_out[l], ln_w[l], ln_b[l])
        (q_a, k_a, v_a, g_a, q_r, k_r, v_r, g_r), gate = _front(x_s, c_sample, w_ada[l], b_ada[l], w_in[l])
        o_a, k_buf, v_buf = _swa_sample(q_a, k_a, v_a, cache_k_win[l], cache_v_win[l], attn_sinks[l])
        q_r = _rotary(q_r, pos_s)
        k_r = _rotary(k_r, pos_s) * (HEAD_DIM_R ** -0.5)
        o_r, S_s = _retention_chunk(q_r, k_r, v_r, state_ret[l], log_gamma)
        ks_l.append(k_buf)
        vs_l.append(v_buf)
        ss_l.append(S_s)
        x_s = _back(x_s, gate, o_a, g_a, o_r, g_r, ret_gn_w[l], w_out[l], ln_w[l], ln_b[l])
    return (x_p, x_s, jnp.stack(kp_l), jnp.stack(vp_l), jnp.stack(sp_l),
            jnp.stack(ks_l), jnp.stack(vs_l), jnp.stack(ss_l))
```

```cpp
#include <hip/hip_runtime.h>
#include <hip/hip_cooperative_groups.h>
#include <cstdio>
namespace cg = cooperative_groups;
__device__ __forceinline__ int opaque_tid() { int t = threadIdx.x; asm volatile("" : "+v"(t)); return t; }
namespace pg8 {
#define PG8_LAS __attribute__((address_space(3)))
typedef unsigned short bf16_t;
typedef short bf16x8 __attribute__((ext_vector_type(8)));
typedef float f32x4 __attribute__((ext_vector_type(4)));
typedef unsigned u32x4 __attribute__((ext_vector_type(4)));
constexpr int BM = 256, BK = 64, HALF = 128, HTB = HALF * BK * 2  , STAGE_BYTES = 8 * HTB, NXCD = 8, WGM = 8;

__host__ __device__ __forceinline__ int lds_byte(int r, int c) { const int st = (r >> 4) * 2 + (c >> 5), rr = r & 15, cc = c & 31, ob = rr * 64 + cc * 2; return st * 1024 + (ob ^ (((ob >> 9) & 1) << 5)); }
__host__ __device__ __forceinline__ void stage_rc(int b, int& R, int& C) { const int st = b / 1024, sb = b % 1024, swz = sb ^ (((sb >> 9) & 1) << 5); R = (st >> 1) * 16 + swz / 64; C = (st & 1) * 32 + (swz % 64) / 2; }
__host__ __device__ __forceinline__ int perm32(int rho) { const int n = rho >> 4, i = rho & 15; return 8 * (i >> 2) + 4 * n + (i & 3); }

struct Unit { int pm, pn; };
struct Gemm { const bf16_t* A; const bf16_t* Bt; int M, N, K; };

struct StaticOrder {
    int nM, nN, nwg, G, c;
    __host__ __device__ void init(int M, int N, int G_, int c_) { nM = M / BM; nN = N / BM; nwg = nM * nN; G = G_; c = c_; }
    __host__ __device__ bool next(int i, Unit& u) const {
        const long L = (long)i * G + c; if (L >= nwg) return false;
        int wgid = (int)L; { const int q = nwg / NXCD, r = nwg % NXCD, xcd = wgid % NXCD, off = wgid / NXCD; wgid = (xcd < r ? xcd * (q + 1) : r * (q + 1) + (xcd - r) * q) + off; }
        const int nig = WGM * nN, gid = wgid / nig, fm = gid * WGM, gsz = (nM - fm) < WGM ? (nM - fm) : WGM;
        u.pm = fm + ((wgid % nig) % gsz); u.pn = (wgid % nig) / gsz; return true;
    }
    __device__ __forceinline__ void a_ready(const Unit&) const {}
    __device__ __forceinline__ void done(const Unit&) const {}
};
__device__ __forceinline__ unsigned cvt_pk_bf16(float lo, float hi) { unsigned r; asm volatile("v_cvt_pk_bf16_f32 %0, %1, %2" : "=v"(r) : "v"(lo), "v"(hi)); return r; }
template <class Epi, class Sched>
__device__ __forceinline__ void gemm_phase(PG8_LAS unsigned char* lds, const Gemm g, const Sched& S, const Epi& E) {
    const int tid = opaque_tid(), wid = __builtin_amdgcn_readfirstlane(tid >> 6), lane = tid & 63, wr = wid >> 2, wc = wid & 3, fr = lane & 15, fq = lane >> 4;
    const int K = g.K, nt = K / BK;
    unsigned voffA[2], voffB[2];
#pragma unroll
    for (int i = 0; i < 2; ++i) { int R, C; stage_rc(tid * 16 + i * 8192, R, C); const int Rb = Epi::PERM ? ((R & ~31) + perm32(R & 31)) : R;
        voffA[i] = (unsigned)(R * K + C) * 2u; voffB[i] = (unsigned)(Rb * K + C) * 2u; }
    const size_t kstep = (size_t)(BK * 2);
    const size_t hstep = (size_t)HALF * K * 2;
    const size_t tstep = 2 * hstep;
    const unsigned ldsw = (unsigned)wid * 1024u;
    const int aoff = lds_byte(wr * 64 + fr, fq * 8), boff = lds_byte(wc * 32 + fr, fq * 8);
#define PG8_SA(b, h) (((b) * 2 + (h)) * HTB)
#define PG8_SB(b, h) ((4 + (b) * 2 + (h)) * HTB)
#define PG8_STAGE(bufoff, gbase, voff) do { _Pragma("unroll") for (int _i = 0; _i < 2; ++_i) \
        __builtin_amdgcn_global_load_lds((const unsigned*)((const char*)(gbase) + (voff)[_i]), (PG8_LAS unsigned*)(lds + (bufoff) + ldsw + _i * 8192), 16, 0, 0); } while (0)
#define PG8_LDA(dst, b, h) do { _Pragma("unroll") for (int m = 0; m < 4; ++m) _Pragma("unroll") for (int k = 0; k < 2; ++k) dst[m][k] = *(const PG8_LAS bf16x8*)(lds + PG8_SA(b, h) + aoff + m * 2048 + k * 1024); } while (0)
#define PG8_LDB(dst, b, h) do { _Pragma("unroll") for (int n = 0; n < 2; ++n) _Pragma("unroll") for (int k = 0; k < 2; ++k) dst[n][k] = *(const PG8_LAS bf16x8*)(lds + PG8_SB(b, h) + boff + n * 2048 + k * 1024); } while (0)
#define PG8_MMA(ai, bj, At, Bt) do { __builtin_amdgcn_s_setprio(1); _Pragma("unroll") for (int m = 0; m < 4; ++m) _Pragma("unroll") for (int n = 0; n < 2; ++n) _Pragma("unroll") for (int k = 0; k < 2; ++k) \
        acc[ai][bj][m][n] = __builtin_amdgcn_mfma_f32_16x16x32_bf16(Bt[n][k], At[m][k], acc[ai][bj][m][n], 0, 0, 0); __builtin_amdgcn_s_setprio(0); } while (0)
#define PG8_WAIT_V(n) asm volatile("s_waitcnt vmcnt(" #n ")" ::: "memory")
#define PG8_WAIT_L(n) asm volatile("s_waitcnt lgkmcnt(" #n ")" ::: "memory")
#define PG8_BAR __builtin_amdgcn_s_barrier()
#define PG8_SCHED __builtin_amdgcn_sched_barrier(0)
    Unit cur, nxt; int ui = 0;
    if (!S.next(0, cur)) return;
    f32x4 acc[2][2][4][2];
#pragma unroll
    for (int a = 0; a < 2; ++a)
#pragma unroll
        for (int b = 0; b < 2; ++b)
#pragma unroll
            for (int m = 0; m < 4; ++m)
#pragma unroll
                for (int n = 0; n < 2; ++n) acc[a][b][m][n] = (f32x4){0.f, 0.f, 0.f, 0.f};
    bf16x8 At[4][2], B0[2][2], B1[2][2];
    const char* cA = (const char*)g.A + (size_t)cur.pm * tstep; const char* cB = (const char*)g.Bt + (size_t)cur.pn * tstep;
    S.a_ready(cur);
    PG8_STAGE(PG8_SB(0, 0), cB, voffB); PG8_STAGE(PG8_SA(0, 0), cA, voffA); PG8_STAGE(PG8_SB(0, 1), cB + hstep, voffB); PG8_STAGE(PG8_SA(0, 1), cA + hstep, voffA);
    if (wr == 1) PG8_BAR;
    PG8_WAIT_V(4); PG8_BAR;
    PG8_STAGE(PG8_SB(1, 0), cB + kstep, voffB); PG8_STAGE(PG8_SA(1, 0), cA + kstep, voffA); PG8_STAGE(PG8_SB(1, 1), cB + hstep + kstep, voffB);
    PG8_WAIT_V(6); PG8_BAR;
    for (;;) {
        const bool has_next = S.next(ui + 1, nxt);
        const char* nA = has_next ? (const char*)g.A + (size_t)nxt.pm * tstep : cA; const char* nB = has_next ? (const char*)g.Bt + (size_t)nxt.pn * tstep : cB;
        for (int t = 0; t < nt; t += 2) {
            const bool last = (t == nt - 2);
            const char* a1 = cA + (size_t)(t + 1) * kstep;
            const char* a2 = last ? nA : cA + (size_t)(t + 2) * kstep; const char* b2 = last ? nB : cB + (size_t)(t + 2) * kstep;
            const char* a3 = a2 + kstep; const char* b3 = b2 + kstep;
            if (last && has_next) S.a_ready(nxt);
            PG8_LDB(B0, 0, 0); PG8_SCHED; PG8_LDA(At, 0, 0); PG8_STAGE(PG8_SA(1, 1), a1 + hstep, voffA);
            PG8_WAIT_L(8); PG8_BAR; PG8_WAIT_L(0); PG8_MMA(0, 0, At, B0); PG8_BAR; PG8_SCHED;
            PG8_LDB(B1, 0, 1); PG8_STAGE(PG8_SB(0, 0), b2, voffB);
            PG8_BAR; PG8_WAIT_L(0); PG8_MMA(0, 1, At, B1); PG8_BAR;
            PG8_LDA(At, 0, 1); PG8_STAGE(PG8_SA(0, 0), a2, voffA);
            PG8_BAR; PG8_WAIT_L(0); PG8_MMA(1, 0, At, B0); PG8_BAR; PG8_SCHED;
            PG8_STAGE(PG8_SB(0, 1), b2 + hstep, voffB);
            PG8_WAIT_V(6); PG8_BAR; PG8_MMA(1, 1, At, B1); PG8_BAR;
            PG8_LDB(B0, 1, 0); PG8_SCHED; PG8_LDA(At, 1, 0); PG8_STAGE(PG8_SA(0, 1), a2 + hstep, voffA);
            PG8_WAIT_L(8); PG8_BAR; PG8_WAIT_L(0); PG8_MMA(0, 0, At, B0); PG8_BAR; PG8_SCHED;
            PG8_LDB(B1, 1, 1); PG8_STAGE(PG8_SB(1, 0), b3, voffB);
            PG8_BAR; PG8_WAIT_L(0); PG8_MMA(0, 1, At, B1); PG8_BAR;
            PG8_LDA(At, 1, 1); PG8_STAGE(PG8_SA(1, 0), a3, voffA);
            PG8_BAR; PG8_WAIT_L(0); PG8_MMA(1, 0, At, B0); PG8_BAR; PG8_SCHED;
            PG8_STAGE(PG8_SB(1, 1), b3 + hstep, voffB);
            PG8_WAIT_V(6); PG8_BAR; PG8_MMA(1, 1, At, B1); PG8_BAR;
        }
        if constexpr (!Epi::AFTER_DRAIN) { E(acc, cur, wr, wc, fr, fq); S.done(cur); }
        if (!has_next) break;
#pragma unroll
        for (int a = 0; a < 2; ++a)
#pragma unroll
            for (int b = 0; b < 2; ++b)
#pragma unroll
                for (int m = 0; m < 4; ++m)
#pragma unroll
                    for (int n = 0; n < 2; ++n) acc[a][b][m][n] = (f32x4){0.f, 0.f, 0.f, 0.f};
        cur = nxt; cA = nA; cB = nB; ++ui;
    }
    PG8_WAIT_V(0);
    if (wr == 0) PG8_BAR;
    PG8_BAR;
    if constexpr (Epi::AFTER_DRAIN) { E.fused(acc, cur, wr, wc, fr, fq, lds, wid, lane); S.done(cur); }
#undef PG8_SA
#undef PG8_SB
#undef PG8_STAGE
#undef PG8_LDA
#undef PG8_LDB
#undef PG8_MMA
#undef PG8_WAIT_V
#undef PG8_WAIT_L
#undef PG8_BAR
#undef PG8_SCHED
}
}

typedef unsigned short bf16_t;
typedef short bf16x8 __attribute__((ext_vector_type(8)));
typedef float f32x4 __attribute__((ext_vector_type(4)));
typedef float f32x16 __attribute__((ext_vector_type(16)));
typedef unsigned u32x4 __attribute__((ext_vector_type(4)));
typedef unsigned u32x2 __attribute__((ext_vector_type(2)));

constexpr int DM = 1024, NPROMPT = 32768, NSAMPLE = 1024, MROWS = NPROMPT + NSAMPLE, DIN = 3328;
constexpr int C_QA = 0, C_KA = 512, C_VA = 640, C_GA = 768, C_QR = 1280, C_KR = 1792, C_VR = 2304, C_GR = 2816;
constexpr float ALPHA = 1.189207115002721f;
constexpr size_t O_Y = 0, O_KWP = 34603008, O_VWP = 34865152, O_SP = 35127296, O_KWS = 36175872, O_VWS = 38273024, O_SS = 40370176;
constexpr size_t MiB = 1u << 20;
constexpr size_t WS_WIN = 0, WS_WOUT = 8 * MiB, WS_COND = 12 * MiB, WS_COS = 16 * MiB, WS_SIN = 17 * MiB, WS_STATS = 20 * MiB,
                 WS_H = 32 * MiB, WS_MIX = 100 * MiB, WS_Z = 168 * MiB;
constexpr int LDS_BYTES = 155648;

struct Params {
    const float* xp; const float* xs; const float* cp; const float* cs; const float* ck; const float* cv; const float* st;
    const float* w_ada; const float* b_ada; const float* w_in; const float* sinks; const float* gn_w; const float* w_out; const float* ln_w; const float* ln_b;
    float* out; unsigned char* ws;
};

__device__ __forceinline__ unsigned cvt_pk(float lo, float hi) { return pg8::cvt_pk_bf16(lo, hi); }
__device__ __forceinline__ float bf_lo(unsigned w) { return __uint_as_float(w << 16); }
__device__ __forceinline__ float bf_hi(unsigned w) { return __uint_as_float(w & 0xffff0000u); }
__device__ __forceinline__ float silu_f(float v) { return v / (1.0f + __expf(-v)); }
__device__ __forceinline__ f32x16 mfma32(bf16x8 a, bf16x8 b, f32x16 c) { return __builtin_amdgcn_mfma_f32_32x32x16_bf16(a, b, c, 0, 0, 0); }
__device__ __forceinline__ f32x4 mfma16(bf16x8 a, bf16x8 b, f32x4 c) { return __builtin_amdgcn_mfma_f32_16x16x32_bf16(a, b, c, 0, 0, 0); }
__device__ __forceinline__ bf16x8 as_frag(u32x4 v) { return __builtin_bit_cast(bf16x8, v); }
__device__ __forceinline__ u32x4 pack8(const float* v) { u32x4 r; r.x = cvt_pk(v[0], v[1]); r.y = cvt_pk(v[2], v[3]); r.z = cvt_pk(v[4], v[5]); r.w = cvt_pk(v[6], v[7]); return r; }

struct EpiZ {
    static constexpr bool PERM = true, AFTER_DRAIN = false;
    bf16_t* Z; float* out;
    __device__ __forceinline__ void operator()(const f32x4 (&acc)[2][2][4][2], const pg8::Unit& u, int wr, int wc, int fr, int fq) const {
        const int row0 = u.pm * 256 + wr * 64 + fr, col0 = u.pn * 256 + wc * 32 + 8 * fq;
#pragma unroll
        for (int ai = 0; ai < 2; ++ai)
#pragma unroll
            for (int m = 0; m < 4; ++m) {
                const int row = row0 + ai * 128 + m * 16;
                bf16_t* rowp = Z + (size_t)row * DIN + col0;
#pragma unroll
                for (int bj = 0; bj < 2; ++bj) {
                    const f32x4 v0 = acc[ai][bj][m][0], v1 = acc[ai][bj][m][1];
                    u32x4 w; w.x = cvt_pk(v0[0], v0[1]); w.y = cvt_pk(v0[2], v0[3]); w.z = cvt_pk(v1[0], v1[1]); w.w = cvt_pk(v1[2], v1[3]);
                    *(u32x4*)(rowp + bj * 128) = w;
                }
                if (u.pn == 2) {
                    long base = -1;
                    size_t vofs = 0;
                    if (row < NPROMPT) { const int b = row >> 11, t = row & 2047; if (t >= 1920) { base = (long)O_KWP + (long)b * 16384 + (long)(t - 1920) * 128; vofs = O_VWP - O_KWP; } }
                    else { const int sr = row - NPROMPT, b = sr >> 3, t = sr & 7; base = (long)O_KWS + (long)b * 16384 + (long)(120 + t) * 128; vofs = O_VWS - O_KWS; }
                    if (base >= 0) {
                        const int cl = wc * 32 + 8 * fq;
#pragma unroll
                        for (int bj = 0; bj < 2; ++bj) {
                            float* dst = out + base + (bj ? vofs : 0) + cl;
                            *(f32x4*)dst = acc[ai][bj][m][0]; *(f32x4*)(dst + 4) = acc[ai][bj][m][1];
                        }
                    }
                }
            }
    }
};
struct EpiR {
    static constexpr bool PERM = false, AFTER_DRAIN = false;
    const float* xp; const float* xs; const float* cond; float* out; float* stats;
    __device__ __forceinline__ void operator()(const f32x4 (&acc)[2][2][4][2], const pg8::Unit& u, int wr, int wc, int fr, int fq) const {
        const int row0 = u.pm * 256 + wr * 64 + fr, col0 = u.pn * 256 + wc * 32 + 4 * fq;
#pragma unroll
        for (int ai = 0; ai < 2; ++ai)
#pragma unroll
            for (int m = 0; m < 4; ++m) {
                const int row = row0 + ai * 128 + m * 16;
                const int crow = row < NPROMPT ? (row >> 11) : 16 + ((row - NPROMPT) >> 3);
                const float* xr = row < NPROMPT ? xp + (size_t)row * DM : xs + (size_t)(row - NPROMPT) * DM;
                const float* gr = cond + (size_t)crow * 3072 + 2048;
                float* orow = out + (size_t)row * DM;
                float s = 0.f, q = 0.f;
#pragma unroll
                for (int bj = 0; bj < 2; ++bj)
#pragma unroll
                    for (int n = 0; n < 2; ++n) {
                        const int c = col0 + bj * 128 + n * 16;
                        const f32x4 xv = *(const f32x4*)(xr + c), gv = *(const f32x4*)(gr + c);
                        const f32x4 r = xv * ALPHA + gv * acc[ai][bj][m][n];
                        *(f32x4*)(orow + c) = r;
                        s += (r[0] + r[1]) + (r[2] + r[3]); q += (r[0] * r[0] + r[1] * r[1]) + (r[2] * r[2] + r[3] * r[3]);
                    }
                s += __shfl_xor(s, 16); s += __shfl_xor(s, 32); q += __shfl_xor(q, 16); q += __shfl_xor(q, 32);
                if (fq == 0) { float* sp = stats + ((size_t)row * 16 + u.pn * 4 + wc) * 2; sp[0] = s; sp[1] = q; }
            }
    }
};

__device__ __forceinline__ void p0_cond(const Params& p, unsigned char* lds, int nblk) {
    bf16_t* Bs = (bf16_t*)lds;
    const int tid = opaque_tid(), w = tid >> 6, lane = tid & 63, n0 = nblk * 16;
    float* cond = (float*)(p.ws + WS_COND);
    for (int idx = tid; idx < 16384; idx += 512) { const int k = idx >> 4, n = idx & 15; Bs[n * 1032 + k] = (bf16_t)(cvt_pk(p.w_ada[(size_t)k * 3072 + n0 + n], 0.f) & 0xffffu); }
    __syncthreads();
    for (int rt = w; rt < 9; rt += 8) {
        const float* crow = rt == 0 ? p.cp + (size_t)(lane & 15) * DM : p.cs + (size_t)((rt - 1) * 16 + (lane & 15)) * DM;
        f32x4 acc = {0.f, 0.f, 0.f, 0.f};
        for (int kk = 0; kk < 32; ++kk) {
            const int k0 = kk * 32 + (lane >> 4) * 8;
            const f32x4 a0 = *(const f32x4*)(crow + k0), a1 = *(const f32x4*)(crow + k0 + 4);
            u32x4 av; av.x = cvt_pk(silu_f(a0[0]), silu_f(a0[1])); av.y = cvt_pk(silu_f(a0[2]), silu_f(a0[3])); av.z = cvt_pk(silu_f(a1[0]), silu_f(a1[1])); av.w = cvt_pk(silu_f(a1[2]), silu_f(a1[3]));
            const bf16x8 bfr = *(const bf16x8*)(Bs + (lane & 15) * 1032 + k0);
            acc = mfma16(as_frag(av), bfr, acc);
        }
        const int n = n0 + (lane & 15);
        const float bias = p.b_ada[n];
#pragma unroll
        for (int j = 0; j < 4; ++j) { const int r = rt * 16 + (lane >> 4) * 4 + j; cond[(size_t)r * 3072 + n] = acc[j] + bias; }
    }
    __syncthreads();
}
__device__ __forceinline__ void p0_transpose(const float* W, bf16_t* Wt, int K, int N, int tile, unsigned char* lds) {
    float* T = (float*)lds;
    const int tid = opaque_tid(), tiles_n = N / 64, kt = tile / tiles_n, nt = tile % tiles_n;
    for (int idx = tid; idx < 4096; idx += 512) { const int k = idx >> 6, n = idx & 63; T[k * 65 + n] = W[(size_t)(kt * 64 + k) * N + nt * 64 + n]; }
    __syncthreads();
    for (int idx = tid; idx < 2048; idx += 512) { const int n = idx >> 5, k = (idx & 31) * 2;
        *(unsigned*)(Wt + (size_t)(nt * 64 + n) * K + kt * 64 + k) = cvt_pk(T[k * 65 + n], T[(k + 1) * 65 + n]); }
    __syncthreads();
}
__device__ __forceinline__ void p0_prologue(const Params& p, unsigned char* lds) {
    const int tid = opaque_tid(), G = gridDim.x, bx = blockIdx.x;
    for (int nb = bx; nb < 192; nb += G) p0_cond(p, lds, nb);
    for (int t = (G - 1 - bx); t < 832 + 256; t += G) {
        if (t < 832) p0_transpose(p.w_in, (bf16_t*)(p.ws + WS_WIN), 1024, DIN, t, lds);
        else p0_transpose(p.w_out, (bf16_t*)(p.ws + WS_WOUT), 1024, 1024, t - 832, lds);
    }
    float* tc = (float*)(p.ws + WS_COS); float* tsn = (float*)(p.ws + WS_SIN);
    for (int idx = bx * 512 + tid; idx < 2056 * 64; idx += G * 512) {
        const int r = idx >> 6, d = idx & 63;
        const float pos = (float)(r < 2048 ? r : 16384 + (r - 2048));
        const float inv = powf(10000.0f, -(float)d / 64.0f);
        const float ang = pos * inv;
        const double a = (double)ang;
        const double nrev = rint(a * 0.15915494309189535);
        const float red = (float)(a - nrev * 6.283185307179586);
        tc[idx] = __cosf(red); tsn[idx] = __sinf(red);
    }
    for (int idx = bx * 512 + tid; idx < 128 * 3840; idx += G * 512) {
        const int b = idx / 3840, e = (idx % 3840) * 4;
        *(f32x4*)(p.out + O_KWS + (size_t)b * 16384 + e) = *(const f32x4*)(p.ck + (size_t)b * 16384 + 1024 + e);
        *(f32x4*)(p.out + O_VWS + (size_t)b * 16384 + e) = *(const f32x4*)(p.cv + (size_t)b * 16384 + 1024 + e);
    }
}
__device__ __forceinline__ void p1a_modulate(const Params& p) {
    const float* cond = (const float*)(p.ws + WS_COND);
    bf16_t* H = (bf16_t*)(p.ws + WS_H);
    for (size_t it = (size_t)blockIdx.x * 512 + threadIdx.x; it < (size_t)MROWS * 128; it += (size_t)gridDim.x * 512) {
        const int row = (int)(it >> 7), c8 = (int)(it & 127) * 8;
        const float* xr = row < NPROMPT ? p.xp + (size_t)row * DM : p.xs + (size_t)(row - NPROMPT) * DM;
        const int crow = row < NPROMPT ? (row >> 11) : 16 + ((row - NPROMPT) >> 3);
        const float* cr = cond + (size_t)crow * 3072;
        const f32x4 x0 = *(const f32x4*)(xr + c8), x1 = *(const f32x4*)(xr + c8 + 4);
        const f32x4 sh0 = *(const f32x4*)(cr + c8), sh1 = *(const f32x4*)(cr + c8 + 4);
        const f32x4 sc0 = *(const f32x4*)(cr + 1024 + c8), sc1 = *(const f32x4*)(cr + 1024 + c8 + 4);
        const f32x4 h0 = x0 * (sc0 + 1.0f) + sh0, h1 = x1 * (sc1 + 1.0f) + sh1;
        u32x4 w; w.x = cvt_pk(h0[0], h0[1]); w.y = cvt_pk(h0[2], h0[3]); w.z = cvt_pk(h1[0], h1[1]); w.w = cvt_pk(h1[2], h1[3]);
        *(u32x4*)(H + (size_t)row * DM + c8) = w;
    }
}
__device__ __forceinline__ void p4_layernorm(const Params& p) {
    const float* stats = (const float*)(p.ws + WS_STATS);
    const int w = threadIdx.x >> 6, lane = threadIdx.x & 63;
    for (int row = blockIdx.x * 8 + w; row < MROWS; row += gridDim.x * 8) {
        float s = 0.f, q = 0.f;
        if (lane < 16) { s = stats[((size_t)row * 16 + lane) * 2]; q = stats[((size_t)row * 16 + lane) * 2 + 1]; }
#pragma unroll
        for (int o = 1; o < 16; o <<= 1) { s += __shfl_xor(s, o); q += __shfl_xor(q, o); }
        s = __shfl(s, 0); q = __shfl(q, 0);
        const float mu = s * (1.0f / 1024.0f), var = q * (1.0f / 1024.0f) - mu * mu, rstd = rsqrtf(var + 1e-5f);
        float* o = p.out + (size_t)row * DM;
#pragma unroll
        for (int i = 0; i < 4; ++i) {
            const int c = (i * 64 + lane) * 4;
            const f32x4 v = *(const f32x4*)(o + c), lw = *(const f32x4*)(p.ln_w + c), lb = *(const f32x4*)(p.ln_b + c);
            *(f32x4*)(o + c) = (v - mu) * rstd * lw + lb;
        }
    }
}

constexpr int R_QS = 0, R_KS = 17408, R_KT = 34816, R_VT = 53248, R_AS = 71680, R_ST = 80896, R_OB = 115712;
constexpr int LDQ = 136, LDT = 72, LDO = 132;

__device__ __forceinline__ void ret_write_st(bf16_t* St, const f32x16 (&Sacc)[2], int kt0, int ct, int l31, int hh) {
#pragma unroll
    for (int t2 = 0; t2 < 2; ++t2)
#pragma unroll
        for (int g4 = 0; g4 < 4; ++g4) {
            const int dk0 = (kt0 + t2) * 32 + 8 * g4 + 4 * hh, dv = ct * 32 + l31;
            u32x2 w; w.x = cvt_pk(Sacc[t2][4 * g4 + 0], Sacc[t2][4 * g4 + 1]); w.y = cvt_pk(Sacc[t2][4 * g4 + 2], Sacc[t2][4 * g4 + 3]);
            *(u32x2*)(St + dv * LDQ + dk0) = w;
        }
}

template <bool SAMPLE>
__device__ __forceinline__ void ret_item(const Params& p, unsigned char* lds, int b, int h) {
    bf16_t* Qs = (bf16_t*)(lds + R_QS); bf16_t* Ks = (bf16_t*)(lds + R_KS); bf16_t* Kt = (bf16_t*)(lds + R_KT); bf16_t* Vt = (bf16_t*)(lds + R_VT);
    bf16_t* As = (bf16_t*)(lds + R_AS); bf16_t* St = (bf16_t*)(lds + R_ST); float* Ob = (float*)(lds + R_OB);
    const bf16_t* Z = (const bf16_t*)(p.ws + WS_Z);
    bf16_t* MX = (bf16_t*)(p.ws + WS_MIX);
    const float* tcs = (const float*)(p.ws + WS_COS); const float* tsn = (const float*)(p.ws + WS_SIN);
    const int tid = opaque_tid(), w = tid >> 6, lane = tid & 63, l31 = lane & 31, hh = lane >> 5;
    const float lg = logf(1.0f - exp2f(-5.0f - (float)h));
    const int nchunk = SAMPLE ? 1 : 32;
    const float gL = expf(lg * (SAMPLE ? 8.0f : 64.0f));
    const size_t rowbase = SAMPLE ? (size_t)NPROMPT + (size_t)b * 8 : (size_t)b * 2048;
    const int ct = w & 3, kt0 = (w >> 2) * 2, rt = w >> 2;
    f32x16 Sacc[2];
    if (SAMPLE) {
        const float* sp = p.st + (size_t)(b * 4 + h) * 16384;
#pragma unroll
        for (int t2 = 0; t2 < 2; ++t2)
#pragma unroll
            for (int r = 0; r < 16; ++r) { const int dk = (kt0 + t2) * 32 + (r & 3) + 8 * (r >> 2) + 4 * hh; Sacc[t2][r] = sp[dk * 128 + ct * 32 + l31]; }
    } else {
#pragma unroll
        for (int t2 = 0; t2 < 2; ++t2)
#pragma unroll
            for (int r = 0; r < 16; ++r) Sacc[t2][r] = 0.f;
    }
    ret_write_st(St, Sacc, kt0, ct, l31, hh);
    for (int c = 0; c < nchunk; ++c) {
        {
            const int i = tid >> 3, dg = tid & 7, d0 = dg * 8;
            const bool valid = !SAMPLE || i < 8;
            const size_t row = rowbase + (size_t)c * 64 + (SAMPLE ? (i & 7) : i);
            const int trow = SAMPLE ? 2048 + (i & 7) : c * 64 + i;
            const float qd = expf(lg * (float)(i + 1)), kd = expf(-lg * (float)(i + 1)) * 0.08838834764831845f;
            const bf16_t* zr = Z + row * DIN;
            const u32x4 q1 = *(const u32x4*)(zr + C_QR + h * 128 + d0), q2 = *(const u32x4*)(zr + C_QR + h * 128 + 64 + d0);
            const u32x4 k1 = *(const u32x4*)(zr + C_KR + h * 128 + d0), k2 = *(const u32x4*)(zr + C_KR + h * 128 + 64 + d0);
            const f32x4 c0 = *(const f32x4*)(tcs + trow * 64 + d0), c1 = *(const f32x4*)(tcs + trow * 64 + d0 + 4);
            const f32x4 s0 = *(const f32x4*)(tsn + trow * 64 + d0), s1 = *(const f32x4*)(tsn + trow * 64 + d0 + 4);
            float qa[8], qb[8], ka[8], kb[8];
#pragma unroll
            for (int e = 0; e < 4; ++e) {
                const unsigned wq1 = q1[e], wq2 = q2[e], wk1 = k1[e], wk2 = k2[e];
#pragma unroll
                for (int hf = 0; hf < 2; ++hf) {
                    const int ee = e * 2 + hf;
                    const float cs = ee < 4 ? c0[ee & 3] : c1[ee & 3], sn = ee < 4 ? s0[ee & 3] : s1[ee & 3];
                    const float x1 = hf ? bf_hi(wq1) : bf_lo(wq1), x2 = hf ? bf_hi(wq2) : bf_lo(wq2);
                    const float y1 = hf ? bf_hi(wk1) : bf_lo(wk1), y2 = hf ? bf_hi(wk2) : bf_lo(wk2);
                    qa[ee] = valid ? (x1 * cs - x2 * sn) * qd : 0.f; qb[ee] = valid ? (x2 * cs + x1 * sn) * qd : 0.f;
                    ka[ee] = valid ? (y1 * cs - y2 * sn) * kd : 0.f; kb[ee] = valid ? (y2 * cs + y1 * sn) * kd : 0.f;
                }
            }
            const u32x4 pqa = pack8(qa), pqb = pack8(qb), pka = pack8(ka), pkb = pack8(kb);
            *(u32x4*)(Qs + i * LDQ + d0) = pqa; *(u32x4*)(Qs + i * LDQ + 64 + d0) = pqb;
            *(u32x4*)(Ks + i * LDQ + d0) = pka; *(u32x4*)(Ks + i * LDQ + 64 + d0) = pkb;
#pragma unroll
            for (int e = 0; e < 4; ++e) {
                Kt[(d0 + 2 * e) * LDT + i] = (bf16_t)(pka[e] & 0xffffu); Kt[(d0 + 2 * e + 1) * LDT + i] = (bf16_t)(pka[e] >> 16);
                Kt[(64 + d0 + 2 * e) * LDT + i] = (bf16_t)(pkb[e] & 0xffffu); Kt[(64 + d0 + 2 * e + 1) * LDT + i] = (bf16_t)(pkb[e] >> 16);
            }
            const int dv0 = dg * 16;
            u32x4 v1 = *(const u32x4*)(zr + C_VR + h * 128 + dv0), v2 = *(const u32x4*)(zr + C_VR + h * 128 + dv0 + 8);
            if (!valid) { v1 = (u32x4){0u, 0u, 0u, 0u}; v2 = v1; }
#pragma unroll
            for (int e = 0; e < 4; ++e) {
                Vt[(dv0 + 2 * e) * LDT + i] = (bf16_t)(v1[e] & 0xffffu); Vt[(dv0 + 2 * e + 1) * LDT + i] = (bf16_t)(v1[e] >> 16);
                Vt[(dv0 + 8 + 2 * e) * LDT + i] = (bf16_t)(v2[e] & 0xffffu); Vt[(dv0 + 8 + 2 * e + 1) * LDT + i] = (bf16_t)(v2[e] >> 16);
            }
        }
        __syncthreads();
#pragma unroll
        for (int tq = 0; tq < 2; ++tq) {
            const int tt = w + tq * 8, jt = tt >> 2, it = tt & 3;
            f32x4 a4 = {0.f, 0.f, 0.f, 0.f};
            if (it >= jt) {
#pragma unroll
                for (int kk = 0; kk < 4; ++kk) {
                    const bf16x8 af = *(const bf16x8*)(Ks + (jt * 16 + (lane & 15)) * LDQ + kk * 32 + (lane >> 4) * 8);
                    const bf16x8 bfr = *(const bf16x8*)(Qs + (it * 16 + (lane & 15)) * LDQ + kk * 32 + (lane >> 4) * 8);
                    a4 = mfma16(af, bfr, a4);
                }
            }
            const int i = it * 16 + (lane & 15), j0 = jt * 16 + 4 * (lane >> 4);
            u32x2 wv; wv.x = cvt_pk(i >= j0 ? a4[0] : 0.f, i >= j0 + 1 ? a4[1] : 0.f); wv.y = cvt_pk(i >= j0 + 2 ? a4[2] : 0.f, i >= j0 + 3 ? a4[3] : 0.f);
            *(u32x2*)(As + i * LDT + j0) = wv;
        }
        __syncthreads();
        {
            f32x16 O;
#pragma unroll
            for (int r = 0; r < 16; ++r) O[r] = 0.f;
            bf16x8 vf[4];
#pragma unroll
            for (int ks = 0; ks < 4; ++ks) vf[ks] = *(const bf16x8*)(Vt + (ct * 32 + l31) * LDT + ks * 16 + 8 * hh);
#pragma unroll
            for (int ks = 0; ks < 4; ++ks) { const bf16x8 af = *(const bf16x8*)(As + (rt * 32 + l31) * LDT + ks * 16 + 8 * hh); O = mfma32(af, vf[ks], O); }
#pragma unroll
            for (int ks = 0; ks < 8; ++ks) {
                const bf16x8 af = *(const bf16x8*)(Qs + (rt * 32 + l31) * LDQ + ks * 16 + 8 * hh);
                const bf16x8 bfr = *(const bf16x8*)(St + (ct * 32 + l31) * LDQ + ks * 16 + 8 * hh);
                O = mfma32(af, bfr, O);
            }
#pragma unroll
            for (int t2 = 0; t2 < 2; ++t2) {
#pragma unroll
                for (int ks = 0; ks < 4; ++ks) { const bf16x8 af = *(const bf16x8*)(Kt + ((kt0 + t2) * 32 + l31) * LDT + ks * 16 + 8 * hh); Sacc[t2] = mfma32(af, vf[ks], Sacc[t2]); }
#pragma unroll
                for (int r = 0; r < 16; ++r) Sacc[t2][r] *= gL;
            }
#pragma unroll
            for (int r = 0; r < 16; ++r) { const int i = rt * 32 + (r & 3) + 8 * (r >> 2) + 4 * hh; Ob[i * LDO + ct * 32 + l31] = O[r]; }
        }
        __syncthreads();
        if (c + 1 < nchunk) ret_write_st(St, Sacc, kt0, ct, l31, hh);
        {
            const int i = tid >> 3, seg = tid & 7, dv0 = seg * 16;
            float o[16];
#pragma unroll
            for (int e4 = 0; e4 < 4; ++e4) { const f32x4 v = *(const f32x4*)(Ob + i * LDO + dv0 + e4 * 4); o[e4 * 4] = v[0]; o[e4 * 4 + 1] = v[1]; o[e4 * 4 + 2] = v[2]; o[e4 * 4 + 3] = v[3]; }
            float s = 0.f;
#pragma unroll
            for (int e = 0; e < 16; ++e) s += o[e];
            s += __shfl_xor(s, 1); s += __shfl_xor(s, 2); s += __shfl_xor(s, 4);
            const float mu = s * (1.0f / 128.0f);
            float q = 0.f;
#pragma unroll
            for (int e = 0; e < 16; ++e) { const float d = o[e] - mu; q += d * d; }
            q += __shfl_xor(q, 1); q += __shfl_xor(q, 2); q += __shfl_xor(q, 4);
            const float rstd = rsqrtf(q * (1.0f / 128.0f) + 1e-5f);
            if (!SAMPLE || i < 8) {
                const size_t row = rowbase + (size_t)c * 64 + i;
                const bf16_t* gp = Z + row * DIN + C_GR + h * 128 + dv0;
                const u32x4 g1 = *(const u32x4*)gp, g2 = *(const u32x4*)(gp + 8);
                const float* gw = p.gn_w + h * 128 + dv0;
                float r8[16];
#pragma unroll
                for (int e = 0; e < 8; ++e) {
                    const unsigned wg = e < 4 ? g1[e & 3] : g2[e & 3];
                    const float ga = bf_lo(wg), gb = bf_hi(wg);
                    r8[2 * e] = (o[2 * e] - mu) * rstd * gw[2 * e] * silu_f(ga);
                    r8[2 * e + 1] = (o[2 * e + 1] - mu) * rstd * gw[2 * e + 1] * silu_f(gb);
                }
                bf16_t* mp = MX + row * DM + 512 + h * 128 + dv0;
                *(u32x4*)mp = pack8(r8); *(u32x4*)(mp + 8) = pack8(r8 + 8);
            }
        }
    }
    float* dst = p.out + (SAMPLE ? O_SS : O_SP) + (size_t)(b * 4 + h) * 16384;
#pragma unroll
    for (int t2 = 0; t2 < 2; ++t2)
#pragma unroll
        for (int r = 0; r < 16; ++r) { const int dk = (kt0 + t2) * 32 + (r & 3) + 8 * (r >> 2) + 4 * hh; dst[dk * 128 + ct * 32 + l31] = Sacc[t2][r]; }
    __syncthreads();
}

constexpr int W_KS = 0, W_VT = 36864;
constexpr int LDK = 72, LDV = 264;

template <bool SAMPLE>
__device__ __forceinline__ void swa_item(const Params& p, unsigned char* lds, int b, int blk, int kvh) {
    bf16_t* Ksw = (bf16_t*)(lds + W_KS); bf16_t* Vtw = (bf16_t*)(lds + W_VT);
    const bf16_t* Z = (const bf16_t*)(p.ws + WS_Z);
    bf16_t* MX = (bf16_t*)(p.ws + WS_MIX);
    const int tid = opaque_tid(), w = tid >> 6, lane = tid & 63, l31 = lane & 31, hh = lane >> 5;
    constexpr int NKEYS = SAMPLE ? 160 : 256;
    for (int idx = tid; idx < NKEYS * 8; idx += 512) {
        const int j = idx >> 3, d0 = (idx & 7) * 8;
        u32x4 kq = {0u, 0u, 0u, 0u}, vq = {0u, 0u, 0u, 0u};
        if (!SAMPLE) {
            const int tk = blk * 128 - 128 + j;
            if (tk >= 0) { const bf16_t* zr = Z + ((size_t)b * 2048 + tk) * DIN; kq = *(const u32x4*)(zr + C_KA + kvh * 64 + d0); vq = *(const u32x4*)(zr + C_VA + kvh * 64 + d0); }
        } else {
            if (j < 128) {
                const float* ckp = p.ck + (((size_t)b * 128 + j) * 2 + kvh) * 64 + d0; const float* cvp = p.cv + (((size_t)b * 128 + j) * 2 + kvh) * 64 + d0;
                const f32x4 a0 = *(const f32x4*)ckp, a1 = *(const f32x4*)(ckp + 4), b0 = *(const f32x4*)cvp, b1 = *(const f32x4*)(cvp + 4);
                kq.x = cvt_pk(a0[0], a0[1]); kq.y = cvt_pk(a0[2], a0[3]); kq.z = cvt_pk(a1[0], a1[1]); kq.w = cvt_pk(a1[2], a1[3]);
                vq.x = cvt_pk(b0[0], b0[1]); vq.y = cvt_pk(b0[2], b0[3]); vq.z = cvt_pk(b1[0], b1[1]); vq.w = cvt_pk(b1[2], b1[3]);
            } else if (j < 136) {
                const bf16_t* zr = Z + ((size_t)NPROMPT + (size_t)b * 8 + (j - 128)) * DIN; kq = *(const u32x4*)(zr + C_KA + kvh * 64 + d0); vq = *(const u32x4*)(zr + C_VA + kvh * 64 + d0);
            }
        }
        *(u32x4*)(Ksw + j * LDK + d0) = kq;
        const int kk = j & 15, jp = (j & ~15) | (((kk >> 2) & 1) << 3) | (((kk >> 3) & 1) << 2) | (kk & 3);
#pragma unroll
        for (int e = 0; e < 4; ++e) { Vtw[(d0 + 2 * e) * LDV + jp] = (bf16_t)(vq[e] & 0xffffu); Vtw[(d0 + 2 * e + 1) * LDV + jp] = (bf16_t)(vq[e] >> 16); }
    }
    __syncthreads();
    if (!SAMPLE || w == 0) {
        const int g = w >> 1;
#pragma unroll 1
        for (int q2 = 0; q2 < (SAMPLE ? 1 : 2); ++q2) {
            const int i0 = SAMPLE ? 0 : ((w & 1) * 2 + q2) * 32;
            const size_t qrow = SAMPLE ? (size_t)NPROMPT + (size_t)b * 8 + (l31 & 7) : (size_t)b * 2048 + blk * 128 + i0 + l31;
            const int head = SAMPLE ? kvh * 4 + (l31 >> 3) : kvh * 4 + g;
            const int iq = SAMPLE ? (l31 & 7) : i0 + l31;
            const float sink = p.sinks[head];
            bf16x8 Qf[4];
#pragma unroll
            for (int ks = 0; ks < 4; ++ks) Qf[ks] = *(const bf16x8*)(Z + qrow * DIN + C_QA + head * 64 + ks * 16 + 8 * hh);
            f32x16 S[5];
#pragma unroll
            for (int kt = 0; kt < 5; ++kt) {
#pragma unroll
                for (int r = 0; r < 16; ++r) S[kt][r] = 0.f;
#pragma unroll
                for (int ks = 0; ks < 4; ++ks) { const bf16x8 kf = *(const bf16x8*)(Ksw + (i0 + 32 * kt + l31) * LDK + ks * 16 + 8 * hh); S[kt] = mfma32(kf, Qf[ks], S[kt]); }
            }
            float m = sink;
#pragma unroll
            for (int kt = 0; kt < 5; ++kt)
#pragma unroll
                for (int r = 0; r < 16; ++r) {
                    const int j = i0 + 32 * kt + (r & 3) + 8 * (r >> 2) + 4 * hh;
                    const bool valid = (j >= iq) && (j <= iq + 128) && (SAMPLE || blk > 0 || j >= 128);
                    const float s = valid ? S[kt][r] * 0.125f : -1e30f;
                    S[kt][r] = s; m = fmaxf(m, s);
                }
            m = fmaxf(m, __shfl_xor(m, 32));
            float sum = 0.f;
#pragma unroll
            for (int kt = 0; kt < 5; ++kt)
#pragma unroll
                for (int r = 0; r < 16; ++r) { const float e = __expf(S[kt][r] - m); S[kt][r] = e; sum += e; }
            sum += __shfl_xor(sum, 32);
            const float inv = 1.0f / (sum + __expf(sink - m));
            f32x16 O[2];
#pragma unroll
            for (int dt = 0; dt < 2; ++dt)
#pragma unroll
                for (int r = 0; r < 16; ++r) O[dt][r] = 0.f;
#pragma unroll
            for (int kt = 0; kt < 5; ++kt)
#pragma unroll
                for (int s2 = 0; s2 < 2; ++s2) {
                    u32x4 pw;
                    pw.x = cvt_pk(S[kt][8 * s2 + 0] * inv, S[kt][8 * s2 + 1] * inv); pw.y = cvt_pk(S[kt][8 * s2 + 2] * inv, S[kt][8 * s2 + 3] * inv);
                    pw.z = cvt_pk(S[kt][8 * s2 + 4] * inv, S[kt][8 * s2 + 5] * inv); pw.w = cvt_pk(S[kt][8 * s2 + 6] * inv, S[kt][8 * s2 + 7] * inv);
#pragma unroll
                    for (int dt = 0; dt < 2; ++dt) { const bf16x8 vfr = *(const bf16x8*)(Vtw + (dt * 32 + l31) * LDV + i0 + 32 * kt + 16 * s2 + 8 * hh); O[dt] = mfma32(as_frag(pw), vfr, O[dt]); }
                }
#pragma unroll
            for (int dt = 0; dt < 2; ++dt)
#pragma unroll
                for (int r = 0; r < 16; ++r) {
                    const int qc = (r & 3) + 8 * (r >> 2) + 4 * hh;
                    const size_t orow = SAMPLE ? (size_t)NPROMPT + (size_t)b * 8 + (qc & 7) : (size_t)b * 2048 + blk * 128 + i0 + qc;
                    const int col = (SAMPLE ? kvh * 4 + (qc >> 3) : kvh * 4 + g) * 64 + dt * 32 + l31;
                    const float gv = __uint_as_float(((unsigned)Z[orow * DIN + C_GA + col]) << 16);
                    MX[orow * DM + col] = (bf16_t)(cvt_pk(O[dt][r] * silu_f(gv), 0.f) & 0xffffu);
                }
        }
    }
    __syncthreads();
}

__device__ __forceinline__ void p2_mixers(const Params& p, unsigned char* lds) {
    const int G = gridDim.x, bx = blockIdx.x;
    const int NRET = 64;
    if (G > NRET) {
        if (bx < NRET) { ret_item<false>(p, lds, bx >> 2, bx & 3); return; }
    } else {
        for (int it = bx; it < NRET; it += G) ret_item<false>(p, lds, it >> 2, it & 3);
    }
    const int nb = G > NRET ? G - NRET : G, me = G > NRET ? bx - NRET : bx;
    for (int it = me; it < 512 + 512 + 256; it += nb) {
        if (it < 512) { swa_item<false>(p, lds, it >> 5, (it >> 1) & 15, it & 1); }
        else if (it < 1024) { const int s = it - 512; ret_item<true>(p, lds, s >> 2, s & 3); }
        else { const int s = it - 1024; swa_item<true>(p, lds, s >> 1, 0, s & 1); }
    }
}

__global__ void __launch_bounds__(512) hymba_fwd(Params p) {
    extern __shared__ __attribute__((aligned(16))) unsigned char lds[];
    cg::grid_group grid = cg::this_grid();
    p0_prologue(p, lds);
    grid.sync();
    p1a_modulate(p);
    grid.sync();
    {
        pg8::Gemm g{(const pg8::bf16_t*)(p.ws + WS_H), (const pg8::bf16_t*)(p.ws + WS_WIN), MROWS, DIN, DM};
        pg8::StaticOrder S; S.init(MROWS, DIN, (int)gridDim.x, (int)blockIdx.x);
        EpiZ E{(bf16_t*)(p.ws + WS_Z), p.out};
        pg8::gemm_phase<EpiZ, pg8::StaticOrder>((PG8_LAS unsigned char*)lds, g, S, E);
    }
    grid.sync();
    p2_mixers(p, lds);
    grid.sync();
    {
        pg8::Gemm g{(const pg8::bf16_t*)(p.ws + WS_MIX), (const pg8::bf16_t*)(p.ws + WS_WOUT), MROWS, DM, DM};
        pg8::StaticOrder S; S.init(MROWS, DM, (int)gridDim.x, (int)blockIdx.x);
        EpiR E{p.xp, p.xs, (const float*)(p.ws + WS_COND), p.out, (float*)(p.ws + WS_STATS)};
        pg8::gemm_phase<EpiR, pg8::StaticOrder>((PG8_LAS unsigned char*)lds, g, S, E);
    }
    grid.sync();
    p4_layernorm(p);
}

extern "C" void kernel_launch(void* const* d_in, const int* in_sizes, int n_in, void* d_out, int out_size, void* d_ws, size_t ws_size, hipStream_t stream) {
    static int grid_blocks = 0;
    if (!grid_blocks) {
        int dev = 0, cus = 0, per_cu = 0;
        hipGetDevice(&dev);
        hipDeviceGetAttribute(&cus, hipDeviceAttributeMultiprocessorCount, dev);
        hipFuncSetAttribute((const void*)hymba_fwd, hipFuncAttributeMaxDynamicSharedMemorySize, LDS_BYTES);
        hipOccupancyMaxActiveBlocksPerMultiprocessor(&per_cu, (const void*)hymba_fwd, 512, LDS_BYTES);
        if (per_cu < 1) { fprintf(stderr, "kernel_launch: occupancy query reports %d blocks per CU\n", per_cu); per_cu = 1; }
        grid_blocks = cus * per_cu;
        if (grid_blocks > 256) grid_blocks = 256;
    }
    Params p{};
    p.xp = (const float*)d_in[0]; p.xs = (const float*)d_in[1]; p.cp = (const float*)d_in[2]; p.cs = (const float*)d_in[3];
    p.ck = (const float*)d_in[4]; p.cv = (const float*)d_in[5]; p.st = (const float*)d_in[6];
    p.w_ada = (const float*)d_in[7]; p.b_ada = (const float*)d_in[8]; p.w_in = (const float*)d_in[9]; p.sinks = (const float*)d_in[10];
    p.gn_w = (const float*)d_in[11]; p.w_out = (const float*)d_in[12]; p.ln_w = (const float*)d_in[13]; p.ln_b = (const float*)d_in[14];
    p.out = (float*)d_out; p.ws = (unsigned char*)d_ws;
    void* args[] = {&p};
    hipError_t e = hipLaunchCooperativeKernel((const void*)hymba_fwd, dim3(grid_blocks), dim3(512), args, LDS_BYTES, stream);
    if (e != hipSuccess) fprintf(stderr, "cooperative launch failed: %s (grid %d)\n", hipGetErrorString(e), grid_blocks);
}
```

```cpp
#include <hip/hip_runtime.h>
#include <hip/hip_cooperative_groups.h>
#include <cstdio>
namespace cg = cooperative_groups;
__device__ __forceinline__ void lds_barrier() { asm volatile("s_waitcnt lgkmcnt(0)" ::: "memory"); __builtin_amdgcn_s_barrier(); asm volatile("" ::: "memory"); }
__device__ __forceinline__ int opaque_tid() { int t = threadIdx.x; asm volatile("" : "+v"(t)); return t; }
namespace pg8 {
#define PG8_LAS __attribute__((address_space(3)))
typedef unsigned short bf16_t;
typedef short bf16x8 __attribute__((ext_vector_type(8)));
typedef float f32x4 __attribute__((ext_vector_type(4)));
typedef unsigned u32x4 __attribute__((ext_vector_type(4)));
constexpr int BM = 256, BK = 64, HALF = 128, HTB = HALF * BK * 2  , STAGE_BYTES = 8 * HTB, NXCD = 8, WGM = 8;

__host__ __device__ __forceinline__ int lds_byte(int r, int c) { const int st = (r >> 4) * 2 + (c >> 5), rr = r & 15, cc = c & 31, ob = rr * 64 + cc * 2; return st * 1024 + (ob ^ (((ob >> 9) & 1) << 5)); }
__host__ __device__ __forceinline__ void stage_rc(int b, int& R, int& C) { const int st = b / 1024, sb = b % 1024, swz = sb ^ (((sb >> 9) & 1) << 5); R = (st >> 1) * 16 + swz / 64; C = (st & 1) * 32 + (swz % 64) / 2; }
__host__ __device__ __forceinline__ int perm32(int rho) { const int n = rho >> 4, i = rho & 15; return 8 * (i >> 2) + 4 * n + (i & 3); }

struct Unit { int pm, pn; };
struct Gemm { const bf16_t* A; const bf16_t* Bt; int M, N, K; };

struct StaticOrder {
    int nM, nN, nwg, G, c;
    __host__ __device__ void init(int M, int N, int G_, int c_) { nM = M / BM; nN = N / BM; nwg = nM * nN; G = G_; c = c_; }
    __host__ __device__ bool next(int i, Unit& u) const {
        const long L = (long)i * G + c; if (L >= nwg) return false;
        int wgid = (int)L; { const int q = nwg / NXCD, r = nwg % NXCD, xcd = wgid % NXCD, off = wgid / NXCD; wgid = (xcd < r ? xcd * (q + 1) : r * (q + 1) + (xcd - r) * q) + off; }
        const int nig = WGM * nN, gid = wgid / nig, fm = gid * WGM, gsz = (nM - fm) < WGM ? (nM - fm) : WGM;
        u.pm = fm + ((wgid % nig) % gsz); u.pn = (wgid % nig) / gsz; return true;
    }
    __device__ __forceinline__ void a_ready(const Unit&) const {}
    __device__ __forceinline__ void done(const Unit&) const {}
};
__device__ __forceinline__ unsigned cvt_pk_bf16(float lo, float hi) { unsigned r; asm volatile("v_cvt_pk_bf16_f32 %0, %1, %2" : "=v"(r) : "v"(lo), "v"(hi)); return r; }
template <class Epi, class Sched>
__device__ __forceinline__ void gemm_phase(PG8_LAS unsigned char* lds, const Gemm g, const Sched& S, const Epi& E) {
    const int tid = opaque_tid(), wid = __builtin_amdgcn_readfirstlane(tid >> 6), lane = tid & 63, wr = wid >> 2, wc = wid & 3, fr = lane & 15, fq = lane >> 4;
    const int K = g.K, nt = K / BK;
    unsigned voffA[2], voffB[2];
#pragma unroll
    for (int i = 0; i < 2; ++i) { int R, C; stage_rc(tid * 16 + i * 8192, R, C); const int Rb = Epi::PERM ? ((R & ~31) + perm32(R & 31)) : R;
        voffA[i] = (unsigned)(R * K + C) * 2u; voffB[i] = (unsigned)(Rb * K + C) * 2u; }
    const size_t kstep = (size_t)(BK * 2);
    const size_t hstep = (size_t)HALF * K * 2;
    const size_t tstep = 2 * hstep;
    const unsigned ldsw = (unsigned)wid * 1024u;
    const int aoff = lds_byte(wr * 64 + fr, fq * 8), boff = lds_byte(wc * 32 + fr, fq * 8);
#define PG8_SA(b, h) (((b) * 2 + (h)) * HTB)
#define PG8_SB(b, h) ((4 + (b) * 2 + (h)) * HTB)
#define PG8_STAGE(bufoff, gbase, voff) do { _Pragma("unroll") for (int _i = 0; _i < 2; ++_i) \
        __builtin_amdgcn_global_load_lds((const unsigned*)((const char*)(gbase) + (voff)[_i]), (PG8_LAS unsigned*)(lds + (bufoff) + ldsw + _i * 8192), 16, 0, 0); } while (0)
#define PG8_LDA(dst, b, h) do { _Pragma("unroll") for (int m = 0; m < 4; ++m) _Pragma("unroll") for (int k = 0; k < 2; ++k) dst[m][k] = *(const PG8_LAS bf16x8*)(lds + PG8_SA(b, h) + aoff + m * 2048 + k * 1024); } while (0)
#define PG8_LDB(dst, b, h) do { _Pragma("unroll") for (int n = 0; n < 2; ++n) _Pragma("unroll") for (int k = 0; k < 2; ++k) dst[n][k] = *(const PG8_LAS bf16x8*)(lds + PG8_SB(b, h) + boff + n * 2048 + k * 1024); } while (0)
#define PG8_MMA(ai, bj, At, Bt) do { __builtin_amdgcn_s_setprio(1); _Pragma("unroll") for (int m = 0; m < 4; ++m) _Pragma("unroll") for (int n = 0; n < 2; ++n) _Pragma("unroll") for (int k = 0; k < 2; ++k) \
        acc[ai][bj][m][n] = __builtin_amdgcn_mfma_f32_16x16x32_bf16(Bt[n][k], At[m][k], acc[ai][bj][m][n], 0, 0, 0); __builtin_amdgcn_s_setprio(0); } while (0)
#define PG8_WAIT_V(n) asm volatile("s_waitcnt vmcnt(" #n ")" ::: "memory")
#define PG8_WAIT_L(n) asm volatile("s_waitcnt lgkmcnt(" #n ")" ::: "memory")
#define PG8_BAR __builtin_amdgcn_s_barrier()
#define PG8_SCHED __builtin_amdgcn_sched_barrier(0)
    Unit cur, nxt; int ui = 0;
    if (!S.next(0, cur)) return;
    f32x4 acc[2][2][4][2];
#pragma unroll
    for (int a = 0; a < 2; ++a)
#pragma unroll
        for (int b = 0; b < 2; ++b)
#pragma unroll
            for (int m = 0; m < 4; ++m)
#pragma unroll
                for (int n = 0; n < 2; ++n) acc[a][b][m][n] = (f32x4){0.f, 0.f, 0.f, 0.f};
    bf16x8 At[4][2], B0[2][2], B1[2][2];
    const char* cA = (const char*)g.A + (size_t)cur.pm * tstep; const char* cB = (const char*)g.Bt + (size_t)cur.pn * tstep;
    S.a_ready(cur);
    PG8_STAGE(PG8_SB(0, 0), cB, voffB); PG8_STAGE(PG8_SA(0, 0), cA, voffA); PG8_STAGE(PG8_SB(0, 1), cB + hstep, voffB); PG8_STAGE(PG8_SA(0, 1), cA + hstep, voffA);
    if (wr == 1) PG8_BAR;
    PG8_WAIT_V(4); PG8_BAR;
    PG8_STAGE(PG8_SB(1, 0), cB + kstep, voffB); PG8_STAGE(PG8_SA(1, 0), cA + kstep, voffA); PG8_STAGE(PG8_SB(1, 1), cB + hstep + kstep, voffB);
    PG8_WAIT_V(6); PG8_BAR;
    for (;;) {
        const bool has_next = S.next(ui + 1, nxt);
        const char* nA = has_next ? (const char*)g.A + (size_t)nxt.pm * tstep : cA; const char* nB = has_next ? (const char*)g.Bt + (size_t)nxt.pn * tstep : cB;
        for (int t = 0; t < nt; t += 2) {
            const bool last = (t == nt - 2);
            const char* a1 = cA + (size_t)(t + 1) * kstep;
            const char* a2 = last ? nA : cA + (size_t)(t + 2) * kstep; const char* b2 = last ? nB : cB + (size_t)(t + 2) * kstep;
            const char* a3 = a2 + kstep; const char* b3 = b2 + kstep;
            if (last && has_next) S.a_ready(nxt);
            PG8_LDB(B0, 0, 0); PG8_SCHED; PG8_LDA(At, 0, 0); PG8_STAGE(PG8_SA(1, 1), a1 + hstep, voffA);
            PG8_WAIT_L(8); PG8_BAR; PG8_WAIT_L(0); PG8_MMA(0, 0, At, B0); PG8_BAR; PG8_SCHED;
            PG8_LDB(B1, 0, 1); PG8_STAGE(PG8_SB(0, 0), b2, voffB);
            PG8_BAR; PG8_WAIT_L(0); PG8_MMA(0, 1, At, B1); PG8_BAR;
            PG8_LDA(At, 0, 1); PG8_STAGE(PG8_SA(0, 0), a2, voffA);
            PG8_BAR; PG8_WAIT_L(0); PG8_MMA(1, 0, At, B0); PG8_BAR; PG8_SCHED;
            PG8_STAGE(PG8_SB(0, 1), b2 + hstep, voffB);
            PG8_WAIT_V(6); PG8_BAR; PG8_MMA(1, 1, At, B1); PG8_BAR;
            PG8_LDB(B0, 1, 0); PG8_SCHED; PG8_LDA(At, 1, 0); PG8_STAGE(PG8_SA(0, 1), a2 + hstep, voffA);
            PG8_WAIT_L(8); PG8_BAR; PG8_WAIT_L(0); PG8_MMA(0, 0, At, B0); PG8_BAR; PG8_SCHED;
            PG8_LDB(B1, 1, 1); PG8_STAGE(PG8_SB(1, 0), b3, voffB);
            PG8_BAR; PG8_WAIT_L(0); PG8_MMA(0, 1, At, B1); PG8_BAR;
            PG8_LDA(At, 1, 1); PG8_STAGE(PG8_SA(1, 0), a3, voffA);
            PG8_BAR; PG8_WAIT_L(0); PG8_MMA(1, 0, At, B0); PG8_BAR; PG8_SCHED;
            PG8_STAGE(PG8_SB(1, 1), b3 + hstep, voffB);
            PG8_WAIT_V(6); PG8_BAR; PG8_MMA(1, 1, At, B1); PG8_BAR;
        }
        if constexpr (!Epi::AFTER_DRAIN) { E(acc, cur, wr, wc, fr, fq); S.done(cur); }
        if (!has_next) break;
#pragma unroll
        for (int a = 0; a < 2; ++a)
#pragma unroll
            for (int b = 0; b < 2; ++b)
#pragma unroll
                for (int m = 0; m < 4; ++m)
#pragma unroll
                    for (int n = 0; n < 2; ++n) acc[a][b][m][n] = (f32x4){0.f, 0.f, 0.f, 0.f};
        cur = nxt; cA = nA; cB = nB; ++ui;
    }
    PG8_WAIT_V(0);
    if (wr == 0) PG8_BAR;
    PG8_BAR;
    if constexpr (Epi::AFTER_DRAIN) { E.fused(acc, cur, wr, wc, fr, fq, lds, wid, lane); S.done(cur); }
#undef PG8_SA
#undef PG8_SB
#undef PG8_STAGE
#undef PG8_LDA
#undef PG8_LDB
#undef PG8_MMA
#undef PG8_WAIT_V
#undef PG8_WAIT_L
#undef PG8_BAR
#undef PG8_SCHED
}
}

typedef unsigned short bf16_t;
typedef short bf16x8 __attribute__((ext_vector_type(8)));
typedef float f32x4 __attribute__((ext_vector_type(4)));
typedef float f32x16 __attribute__((ext_vector_type(16)));
typedef unsigned u32x4 __attribute__((ext_vector_type(4)));
typedef unsigned u32x2 __attribute__((ext_vector_type(2)));

constexpr int DM = 1024, NPROMPT = 32768, NSAMPLE = 1024, MROWS = NPROMPT + NSAMPLE, DIN = 3328;
constexpr int C_QA = 0, C_KA = 512, C_VA = 640, C_GA = 768, C_QR = 1280, C_KR = 1792, C_VR = 2304, C_GR = 2816;
constexpr float ALPHA = 1.189207115002721f;
constexpr size_t O_Y = 0, O_KWP = 34603008, O_VWP = 34865152, O_SP = 35127296, O_KWS = 36175872, O_VWS = 38273024, O_SS = 40370176;
constexpr size_t MiB = 1u << 20;
constexpr size_t WS_WIN = 0, WS_WOUT = 8 * MiB, WS_COND = 12 * MiB, WS_COS = 16 * MiB, WS_SIN = 17 * MiB, WS_STATS = 20 * MiB,
                 WS_H = 32 * MiB, WS_Y = 32 * MiB, WS_MIX = 100 * MiB, WS_Z = 168 * MiB;
constexpr int LDS_BYTES = 155648;

struct Params {
    const float* xp; const float* xs; const float* cp; const float* cs; const float* ck; const float* cv; const float* st;
    const float* w_ada; const float* b_ada; const float* w_in; const float* sinks; const float* gn_w; const float* w_out; const float* ln_w; const float* ln_b;
    float* out; unsigned char* ws;
};

__device__ __forceinline__ unsigned cvt_pk(float lo, float hi) { return pg8::cvt_pk_bf16(lo, hi); }
__device__ __forceinline__ float bf_lo(unsigned w) { return __uint_as_float(w << 16); }
__device__ __forceinline__ float bf_hi(unsigned w) { return __uint_as_float(w & 0xffff0000u); }
__device__ __forceinline__ float silu_f(float v) { return v * __builtin_amdgcn_rcpf(1.0f + __expf(-v)); }
__device__ __forceinline__ f32x16 mfma32(bf16x8 a, bf16x8 b, f32x16 c) { return __builtin_amdgcn_mfma_f32_32x32x16_bf16(a, b, c, 0, 0, 0); }
__device__ __forceinline__ f32x4 mfma16(bf16x8 a, bf16x8 b, f32x4 c) { return __builtin_amdgcn_mfma_f32_16x16x32_bf16(a, b, c, 0, 0, 0); }
__device__ __forceinline__ bf16x8 as_frag(u32x4 v) { return __builtin_bit_cast(bf16x8, v); }
__device__ __forceinline__ u32x4 pack8(const float* v) { u32x4 r; r.x = cvt_pk(v[0], v[1]); r.y = cvt_pk(v[2], v[3]); r.z = cvt_pk(v[4], v[5]); r.w = cvt_pk(v[6], v[7]); return r; }

struct EpiZ {
    static constexpr bool PERM = true, AFTER_DRAIN = false;
    bf16_t* Z; float* out;
    __device__ __forceinline__ void operator()(const f32x4 (&acc)[2][2][4][2], const pg8::Unit& u, int wr, int wc, int fr, int fq) const {
        const int row0 = u.pm * 256 + wr * 64 + fr, col0 = u.pn * 256 + wc * 32 + 8 * fq;
#pragma unroll
        for (int ai = 0; ai < 2; ++ai)
#pragma unroll
            for (int m = 0; m < 4; ++m) {
                const int row = row0 + ai * 128 + m * 16;
                bf16_t* rowp = Z + (size_t)row * DIN + col0;
#pragma unroll
                for (int bj = 0; bj < 2; ++bj) {
                    const f32x4 v0 = acc[ai][bj][m][0], v1 = acc[ai][bj][m][1];
                    u32x4 w; w.x = cvt_pk(v0[0], v0[1]); w.y = cvt_pk(v0[2], v0[3]); w.z = cvt_pk(v1[0], v1[1]); w.w = cvt_pk(v1[2], v1[3]);
                    *(u32x4*)(rowp + bj * 128) = w;
                }
                if (u.pn == 2) {
                    long base = -1;
                    size_t vofs = 0;
                    if (row < NPROMPT) { const int b = row >> 11, t = row & 2047; if (t >= 1920) { base = (long)O_KWP + (long)b * 16384 + (long)(t - 1920) * 128; vofs = O_VWP - O_KWP; } }
                    else { const int sr = row - NPROMPT, b = sr >> 3, t = sr & 7; base = (long)O_KWS + (long)b * 16384 + (long)(120 + t) * 128; vofs = O_VWS - O_KWS; }
                    if (base >= 0) {
                        const int cl = wc * 32 + 8 * fq;
#pragma unroll
                        for (int bj = 0; bj < 2; ++bj) {
                            float* dst = out + base + (bj ? vofs : 0) + cl;
                            *(f32x4*)dst = acc[ai][bj][m][0]; *(f32x4*)(dst + 4) = acc[ai][bj][m][1];
                        }
                    }
                }
            }
    }
};
struct EpiY {
    static constexpr bool PERM = true, AFTER_DRAIN = false;
    bf16_t* Y;
    __device__ __forceinline__ void operator()(const f32x4 (&acc)[2][2][4][2], const pg8::Unit& u, int wr, int wc, int fr, int fq) const {
        const int row0 = u.pm * 256 + wr * 64 + fr, col0 = u.pn * 256 + wc * 32 + 8 * fq;
#pragma unroll
        for (int ai = 0; ai < 2; ++ai)
#pragma unroll
            for (int m = 0; m < 4; ++m) {
                bf16_t* rowp = Y + (size_t)(row0 + ai * 128 + m * 16) * DM + col0;
#pragma unroll
                for (int bj = 0; bj < 2; ++bj) {
                    const f32x4 v0 = acc[ai][bj][m][0], v1 = acc[ai][bj][m][1];
                    u32x4 w; w.x = cvt_pk(v0[0], v0[1]); w.y = cvt_pk(v0[2], v0[3]); w.z = cvt_pk(v1[0], v1[1]); w.w = cvt_pk(v1[2], v1[3]);
                    *(u32x4*)(rowp + bj * 128) = w;
                }
            }
    }
};

__device__ __forceinline__ void p0_cond(const Params& p, unsigned char* lds, int nblk) {
    bf16_t* Bs = (bf16_t*)lds;
    const int tid = opaque_tid(), w = tid >> 6, lane = tid & 63, n0 = nblk * 16;
    float* cond = (float*)(p.ws + WS_COND);
    {
        float wv[32];
#pragma unroll
        for (int it = 0; it < 32; ++it) { const int idx = tid + it * 512; wv[it] = p.w_ada[(size_t)(idx >> 4) * 3072 + n0 + (idx & 15)]; }
#pragma unroll
        for (int it = 0; it < 32; ++it) { const int idx = tid + it * 512; Bs[(idx & 15) * 1032 + (idx >> 4)] = (bf16_t)(cvt_pk(wv[it], 0.f) & 0xffffu); }
    }
    __syncthreads();
    {
        f32x4 acc[9];
#pragma unroll
        for (int rt = 0; rt < 9; ++rt) acc[rt] = (f32x4){0.f, 0.f, 0.f, 0.f};
#pragma unroll
        for (int ks = 0; ks < 4; ++ks) {
            const int k0 = w * 128 + ks * 32 + (lane >> 4) * 8;
            const bf16x8 bfr = *(const bf16x8*)(Bs + (lane & 15) * 1032 + k0);
#pragma unroll
            for (int rt = 0; rt < 9; ++rt) {
                const float* crow = rt == 0 ? p.cp + (size_t)(lane & 15) * DM : p.cs + (size_t)((rt - 1) * 16 + (lane & 15)) * DM;
                const f32x4 a0 = *(const f32x4*)(crow + k0), a1 = *(const f32x4*)(crow + k0 + 4);
                u32x4 av; av.x = cvt_pk(silu_f(a0[0]), silu_f(a0[1])); av.y = cvt_pk(silu_f(a0[2]), silu_f(a0[3])); av.z = cvt_pk(silu_f(a1[0]), silu_f(a1[1])); av.w = cvt_pk(silu_f(a1[2]), silu_f(a1[3]));
                acc[rt] = mfma16(as_frag(av), bfr, acc[rt]);
            }
        }
        f32x4* part = (f32x4*)(lds + 40960);
#pragma unroll
        for (int rt = 0; rt < 9; ++rt) part[(w * 9 + rt) * 64 + lane] = acc[rt];
        __syncthreads();
        for (int t = tid; t < 576; t += 512) {
            const int rt = t >> 6, l = t & 63;
            f32x4 sum = {0.f, 0.f, 0.f, 0.f};
#pragma unroll
            for (int w2 = 0; w2 < 8; ++w2) sum += part[(w2 * 9 + rt) * 64 + l];
            const int n = n0 + (l & 15);
            const float bias = p.b_ada[n];
#pragma unroll
            for (int j = 0; j < 4; ++j) { const int r = rt * 16 + (l >> 4) * 4 + j; cond[(size_t)r * 3072 + n] = sum[j] + bias; }
        }
    }
    __syncthreads();
}
__device__ __forceinline__ void p0_transpose(const float* W, bf16_t* Wt, int K, int N, int tile, unsigned char* lds) {
    float* T = (float*)lds;
    const int tid = opaque_tid(), tiles_n = N / 64, kt = tile / tiles_n, nt = tile % tiles_n;
    for (int idx = tid; idx < 4096; idx += 512) { const int k = idx >> 6, n = idx & 63; T[k * 65 + n] = W[(size_t)(kt * 64 + k) * N + nt * 64 + n]; }
    __syncthreads();
    for (int idx = tid; idx < 2048; idx += 512) { const int n = idx >> 5, k = (idx & 31) * 2;
        *(unsigned*)(Wt + (size_t)(nt * 64 + n) * K + kt * 64 + k) = cvt_pk(T[k * 65 + n], T[(k + 1) * 65 + n]); }
    __syncthreads();
}
__device__ __forceinline__ void p0_prologue(const Params& p, unsigned char* lds) {
    const int tid = opaque_tid(), G = gridDim.x, bx = blockIdx.x;
    for (int nb = bx; nb < 192; nb += G) p0_cond(p, lds, nb);
    for (int t = (G - 1 - bx); t < 832 + 256; t += G) {
        if (t < 832) p0_transpose(p.w_in, (bf16_t*)(p.ws + WS_WIN), 1024, DIN, t, lds);
        else p0_transpose(p.w_out, (bf16_t*)(p.ws + WS_WOUT), 1024, 1024, t - 832, lds);
    }
    float* tc = (float*)(p.ws + WS_COS); float* tsn = (float*)(p.ws + WS_SIN);
    for (int idx = bx * 512 + tid; idx < 2056 * 64; idx += G * 512) {
        const int r = idx >> 6, d = idx & 63;
        const float pos = (float)(r < 2048 ? r : 16384 + (r - 2048));
        const float inv = powf(10000.0f, -(float)d / 64.0f);
        const float ang = pos * inv;
        const double a = (double)ang;
        const double nrev = rint(a * 0.15915494309189535);
        const float red = (float)(a - nrev * 6.283185307179586);
        tc[idx] = __cosf(red); tsn[idx] = __sinf(red);
    }
    for (int idx = bx * 512 + tid; idx < 128 * 3840; idx += G * 512) {
        const int b = idx / 3840, e = (idx % 3840) * 4;
        *(f32x4*)(p.out + O_KWS + (size_t)b * 16384 + e) = *(const f32x4*)(p.ck + (size_t)b * 16384 + 1024 + e);
        *(f32x4*)(p.out + O_VWS + (size_t)b * 16384 + e) = *(const f32x4*)(p.cv + (size_t)b * 16384 + 1024 + e);
    }
}
__device__ __forceinline__ void p1a_modulate(const Params& p) {
    const float* cond = (const float*)(p.ws + WS_COND);
    bf16_t* H = (bf16_t*)(p.ws + WS_H);
    for (size_t it = (size_t)blockIdx.x * 512 + threadIdx.x; it < (size_t)MROWS * 128; it += (size_t)gridDim.x * 512) {
        const int row = (int)(it >> 7), c8 = (int)(it & 127) * 8;
        const float* xr = row < NPROMPT ? p.xp + (size_t)row * DM : p.xs + (size_t)(row - NPROMPT) * DM;
        const int crow = row < NPROMPT ? (row >> 11) : 16 + ((row - NPROMPT) >> 3);
        const float* cr = cond + (size_t)crow * 3072;
        const f32x4 x0 = *(const f32x4*)(xr + c8), x1 = *(const f32x4*)(xr + c8 + 4);
        const f32x4 sh0 = *(const f32x4*)(cr + c8), sh1 = *(const f32x4*)(cr + c8 + 4);
        const f32x4 sc0 = *(const f32x4*)(cr + 1024 + c8), sc1 = *(const f32x4*)(cr + 1024 + c8 + 4);
        const f32x4 h0 = x0 * (sc0 + 1.0f) + sh0, h1 = x1 * (sc1 + 1.0f) + sh1;
        u32x4 w; w.x = cvt_pk(h0[0], h0[1]); w.y = cvt_pk(h0[2], h0[3]); w.z = cvt_pk(h1[0], h1[1]); w.w = cvt_pk(h1[2], h1[3]);
        *(u32x4*)(H + (size_t)row * DM + c8) = w;
    }
}
__device__ __forceinline__ void p4_layernorm(const Params& p) {
    const float* cond = (const float*)(p.ws + WS_COND);
    const bf16_t* Y = (const bf16_t*)(p.ws + WS_Y);
    const int w = threadIdx.x >> 6, lane = threadIdx.x & 63;
    for (int row0 = (blockIdx.x * 8 + w) * 2; row0 < MROWS; row0 += gridDim.x * 16) {
        f32x4 r[2][4];
#pragma unroll
        for (int rr = 0; rr < 2; ++rr) {
            const int row = row0 + rr;
            const float* xr = row < NPROMPT ? p.xp + (size_t)row * DM : p.xs + (size_t)(row - NPROMPT) * DM;
            const int crow = row < NPROMPT ? (row >> 11) : 16 + ((row - NPROMPT) >> 3);
            const float* gr = cond + (size_t)crow * 3072 + 2048;
            const bf16_t* yr = Y + (size_t)row * DM;
#pragma unroll
            for (int i = 0; i < 4; ++i) {
                const int c = (i * 64 + lane) * 4;
                const f32x4 xv = *(const f32x4*)(xr + c), gv = *(const f32x4*)(gr + c);
                const u32x2 yw = *(const u32x2*)(yr + c);
                f32x4 yv; yv[0] = bf_lo(yw.x); yv[1] = bf_hi(yw.x); yv[2] = bf_lo(yw.y); yv[3] = bf_hi(yw.y);
                r[rr][i] = xv * ALPHA + gv * yv;
            }
        }
#pragma unroll
        for (int rr = 0; rr < 2; ++rr) {
            float s = 0.f;
#pragma unroll
            for (int i = 0; i < 4; ++i) s += (r[rr][i][0] + r[rr][i][1]) + (r[rr][i][2] + r[rr][i][3]);
#pragma unroll
            for (int o = 1; o < 64; o <<= 1) s += __shfl_xor(s, o);
            const float mu = s * (1.0f / 1024.0f);
            float q = 0.f;
#pragma unroll
            for (int i = 0; i < 4; ++i) { const f32x4 d = r[rr][i] - mu; q += (d[0] * d[0] + d[1] * d[1]) + (d[2] * d[2] + d[3] * d[3]); }
#pragma unroll
            for (int o = 1; o < 64; o <<= 1) q += __shfl_xor(q, o);
            const float rstd = rsqrtf(q * (1.0f / 1024.0f) + 1e-5f);
            float* o = p.out + (size_t)(row0 + rr) * DM;
#pragma unroll
            for (int i = 0; i < 4; ++i) {
                const int c = (i * 64 + lane) * 4;
                const f32x4 lw = *(const f32x4*)(p.ln_w + c), lb = *(const f32x4*)(p.ln_b + c);
                *(f32x4*)(o + c) = (r[rr][i] - mu) * rstd * lw + lb;
            }
        }
    }
}

constexpr int R_QS = 0, R_KS = 17408, R_KT = 34816, R_VT = 55296, R_AS = 75776, R_ST = 84992, R_OB = 119808;
constexpr int LDQ = 136, LDT = 80, LDA = 72, LDO = 132;

__device__ __forceinline__ void ret_write_st(bf16_t* St, const f32x16 (&Sacc)[2], int kt0, int ct, int l31, int hh) {
#pragma unroll
    for (int t2 = 0; t2 < 2; ++t2)
#pragma unroll
        for (int g4 = 0; g4 < 4; ++g4) {
            const int dk0 = (kt0 + t2) * 32 + 8 * g4 + 4 * hh, dv = ct * 32 + l31;
            u32x2 w; w.x = cvt_pk(Sacc[t2][4 * g4 + 0], Sacc[t2][4 * g4 + 1]); w.y = cvt_pk(Sacc[t2][4 * g4 + 2], Sacc[t2][4 * g4 + 3]);
            *(u32x2*)(St + dv * LDQ + dk0) = w;
        }
}

template <bool SAMPLE>
__device__ __forceinline__ void ret_item(const Params& p, unsigned char* lds, int b, int h) {
    bf16_t* Qs = (bf16_t*)(lds + R_QS); bf16_t* Ks = (bf16_t*)(lds + R_KS); bf16_t* Kt = (bf16_t*)(lds + R_KT); bf16_t* Vt = (bf16_t*)(lds + R_VT);
    bf16_t* As = (bf16_t*)(lds + R_AS); bf16_t* St = (bf16_t*)(lds + R_ST); float* Ob = (float*)(lds + R_OB);
    const bf16_t* Z = (const bf16_t*)(p.ws + WS_Z);
    bf16_t* MX = (bf16_t*)(p.ws + WS_MIX);
    const float* tcs = (const float*)(p.ws + WS_COS); const float* tsn = (const float*)(p.ws + WS_SIN);
    const int tid = opaque_tid(), w = tid >> 6, lane = tid & 63, l31 = lane & 31, hh = lane >> 5;
    const float lg = logf(1.0f - exp2f(-5.0f - (float)h));
    const int nchunk = SAMPLE ? 1 : 32;
    const float gL = expf(lg * (SAMPLE ? 8.0f : 64.0f));
    const size_t rowbase = SAMPLE ? (size_t)NPROMPT + (size_t)b * 8 : (size_t)b * 2048;
    const int ct = w & 3, kt0 = (w >> 2) * 2, rt = w >> 2;
    const int si = lane, sd0 = w * 8, sdv0 = w * 16;
    const bool svalid = !SAMPLE || si < 8;
    const float qd = expf(lg * (float)(si + 1)), kd = expf(-lg * (float)(si + 1)) * 0.08838834764831845f;
    const int gi = tid >> 3, gdv0 = (tid & 7) * 16;
    float gwv[16];
#pragma unroll
    for (int e = 0; e < 16; ++e) gwv[e] = p.gn_w[h * 128 + gdv0 + e];
    u32x4 q1, q2, k1, k2, v1, v2, gn1, gn2, gc1, gc2; f32x4 c0, c1, s0, s1;
#define RET_LOAD(cc) do { \
        const size_t _row = rowbase + (size_t)(cc) * 64 + (SAMPLE ? (si & 7) : si); \
        const int _trow = SAMPLE ? 2048 + (si & 7) : (cc) * 64 + si; \
        const bf16_t* _zr = Z + _row * DIN; \
        q1 = *(const u32x4*)(_zr + C_QR + h * 128 + sd0); q2 = *(const u32x4*)(_zr + C_QR + h * 128 + 64 + sd0); \
        k1 = *(const u32x4*)(_zr + C_KR + h * 128 + sd0); k2 = *(const u32x4*)(_zr + C_KR + h * 128 + 64 + sd0); \
        v1 = *(const u32x4*)(_zr + C_VR + h * 128 + sdv0); v2 = *(const u32x4*)(_zr + C_VR + h * 128 + sdv0 + 8); \
        c0 = *(const f32x4*)(tcs + _trow * 64 + sd0); c1 = *(const f32x4*)(tcs + _trow * 64 + sd0 + 4); \
        s0 = *(const f32x4*)(tsn + _trow * 64 + sd0); s1 = *(const f32x4*)(tsn + _trow * 64 + sd0 + 4); \
        const size_t _grow = rowbase + (size_t)(cc) * 64 + (SAMPLE ? (gi & 7) : gi); \
        const bf16_t* _gp = Z + _grow * DIN + C_GR + h * 128 + gdv0; \
        gn1 = *(const u32x4*)_gp; gn2 = *(const u32x4*)(_gp + 8); } while (0)
    RET_LOAD(0);
    f32x16 Sacc[2];
    if (SAMPLE) {
        const float* sp = p.st + (size_t)(b * 4 + h) * 16384;
#pragma unroll
        for (int t2 = 0; t2 < 2; ++t2)
#pragma unroll
            for (int r = 0; r < 16; ++r) { const int dk = (kt0 + t2) * 32 + (r & 3) + 8 * (r >> 2) + 4 * hh; Sacc[t2][r] = sp[dk * 128 + ct * 32 + l31]; }
    } else {
#pragma unroll
        for (int t2 = 0; t2 < 2; ++t2)
#pragma unroll
            for (int r = 0; r < 16; ++r) Sacc[t2][r] = 0.f;
    }
    ret_write_st(St, Sacc, kt0, ct, l31, hh);
    for (int c = 0; c < nchunk; ++c) {
        {
            float qa[8], qb[8], ka[8], kb[8];
#pragma unroll
            for (int e = 0; e < 4; ++e) {
                const unsigned wq1 = q1[e], wq2 = q2[e], wk1 = k1[e], wk2 = k2[e];
#pragma unroll
                for (int hf = 0; hf < 2; ++hf) {
                    const int ee = e * 2 + hf;
                    const float cs = ee < 4 ? c0[ee & 3] : c1[ee & 3], sn = ee < 4 ? s0[ee & 3] : s1[ee & 3];
                    const float x1 = hf ? bf_hi(wq1) : bf_lo(wq1), x2 = hf ? bf_hi(wq2) : bf_lo(wq2);
                    const float y1 = hf ? bf_hi(wk1) : bf_lo(wk1), y2 = hf ? bf_hi(wk2) : bf_lo(wk2);
                    qa[ee] = svalid ? (x1 * cs - x2 * sn) * qd : 0.f; qb[ee] = svalid ? (x2 * cs + x1 * sn) * qd : 0.f;
                    ka[ee] = svalid ? (y1 * cs - y2 * sn) * kd : 0.f; kb[ee] = svalid ? (y2 * cs + y1 * sn) * kd : 0.f;
                }
            }
            const u32x4 pqa = pack8(qa), pqb = pack8(qb), pka = pack8(ka), pkb = pack8(kb);
            *(u32x4*)(Qs + si * LDQ + sd0) = pqa; *(u32x4*)(Qs + si * LDQ + 64 + sd0) = pqb;
            *(u32x4*)(Ks + si * LDQ + sd0) = pka; *(u32x4*)(Ks + si * LDQ + 64 + sd0) = pkb;
#pragma unroll
            for (int e = 0; e < 4; ++e) {
                Kt[(sd0 + 2 * e) * LDT + si] = (bf16_t)(pka[e] & 0xffffu); Kt[(sd0 + 2 * e + 1) * LDT + si] = (bf16_t)(pka[e] >> 16);
                Kt[(64 + sd0 + 2 * e) * LDT + si] = (bf16_t)(pkb[e] & 0xffffu); Kt[(64 + sd0 + 2 * e + 1) * LDT + si] = (bf16_t)(pkb[e] >> 16);
            }
            if (!svalid) { v1 = (u32x4){0u, 0u, 0u, 0u}; v2 = v1; }
#pragma unroll
            for (int e = 0; e < 4; ++e) {
                Vt[(sdv0 + 2 * e) * LDT + si] = (bf16_t)(v1[e] & 0xffffu); Vt[(sdv0 + 2 * e + 1) * LDT + si] = (bf16_t)(v1[e] >> 16);
                Vt[(sdv0 + 8 + 2 * e) * LDT + si] = (bf16_t)(v2[e] & 0xffffu); Vt[(sdv0 + 8 + 2 * e + 1) * LDT + si] = (bf16_t)(v2[e] >> 16);
            }
            gc1 = gn1; gc2 = gn2;
        }
        if (c + 1 < nchunk) RET_LOAD(c + 1);
        lds_barrier();
#pragma unroll
        for (int tq = 0; tq < 2; ++tq) {
            const int tt = w + tq * 8, jt = tt >> 2, it = tt & 3;
            f32x4 a4 = {0.f, 0.f, 0.f, 0.f};
            if (it >= jt) {
#pragma unroll
                for (int kk = 0; kk < 4; ++kk) {
                    const bf16x8 af = *(const bf16x8*)(Ks + (jt * 16 + (lane & 15)) * LDQ + kk * 32 + (lane >> 4) * 8);
                    const bf16x8 bfr = *(const bf16x8*)(Qs + (it * 16 + (lane & 15)) * LDQ + kk * 32 + (lane >> 4) * 8);
                    a4 = mfma16(af, bfr, a4);
                }
            }
            const int i = it * 16 + (lane & 15), j0 = jt * 16 + 4 * (lane >> 4);
            u32x2 wv; wv.x = cvt_pk(i >= j0 ? a4[0] : 0.f, i >= j0 + 1 ? a4[1] : 0.f); wv.y = cvt_pk(i >= j0 + 2 ? a4[2] : 0.f, i >= j0 + 3 ? a4[3] : 0.f);
            *(u32x2*)(As + i * LDA + j0) = wv;
        }
        lds_barrier();
        {
            f32x16 O;
#pragma unroll
            for (int r = 0; r < 16; ++r) O[r] = 0.f;
            bf16x8 vf[4];
#pragma unroll
            for (int ks = 0; ks < 4; ++ks) vf[ks] = *(const bf16x8*)(Vt + (ct * 32 + l31) * LDT + ks * 16 + 8 * hh);
#pragma unroll
            for (int ks = 0; ks < 4; ++ks) { const bf16x8 af = *(const bf16x8*)(As + (rt * 32 + l31) * LDA + ks * 16 + 8 * hh); O = mfma32(af, vf[ks], O); }
#pragma unroll
            for (int ks = 0; ks < 8; ++ks) {
                const bf16x8 af = *(const bf16x8*)(Qs + (rt * 32 + l31) * LDQ + ks * 16 + 8 * hh);
                const bf16x8 bfr = *(const bf16x8*)(St + (ct * 32 + l31) * LDQ + ks * 16 + 8 * hh);
                O = mfma32(af, bfr, O);
            }
#pragma unroll
            for (int t2 = 0; t2 < 2; ++t2) {
#pragma unroll
                for (int ks = 0; ks < 4; ++ks) { const bf16x8 af = *(const bf16x8*)(Kt + ((kt0 + t2) * 32 + l31) * LDT + ks * 16 + 8 * hh); Sacc[t2] = mfma32(af, vf[ks], Sacc[t2]); }
#pragma unroll
                for (int r = 0; r < 16; ++r) Sacc[t2][r] *= gL;
            }
#pragma unroll
            for (int r = 0; r < 16; ++r) { const int i = rt * 32 + (r & 3) + 8 * (r >> 2) + 4 * hh; Ob[i * LDO + ct * 32 + l31] = O[r]; }
        }
        lds_barrier();
        if (c + 1 < nchunk) ret_write_st(St, Sacc, kt0, ct, l31, hh);
        {
            float o[16];
#pragma unroll
            for (int e4 = 0; e4 < 4; ++e4) { const f32x4 v = *(const f32x4*)(Ob + gi * LDO + gdv0 + e4 * 4); o[e4 * 4] = v[0]; o[e4 * 4 + 1] = v[1]; o[e4 * 4 + 2] = v[2]; o[e4 * 4 + 3] = v[3]; }
            float s = 0.f;
#pragma unroll
            for (int e = 0; e < 16; ++e) s += o[e];
            s += __shfl_xor(s, 1); s += __shfl_xor(s, 2); s += __shfl_xor(s, 4);
            const float mu = s * (1.0f / 128.0f);
            float q = 0.f;
#pragma unroll
            for (int e = 0; e < 16; ++e) { const float d = o[e] - mu; q += d * d; }
            q += __shfl_xor(q, 1); q += __shfl_xor(q, 2); q += __shfl_xor(q, 4);
            const float rstd = rsqrtf(q * (1.0f / 128.0f) + 1e-5f);
            if (!SAMPLE || gi < 8) {
                const size_t row = rowbase + (size_t)c * 64 + gi;
                float r8[16];
#pragma unroll
                for (int e = 0; e < 8; ++e) {
                    const unsigned wg = e < 4 ? gc1[e & 3] : gc2[e & 3];
                    const float ga = bf_lo(wg), gb = bf_hi(wg);
                    r8[2 * e] = (o[2 * e] - mu) * rstd * gwv[2 * e] * silu_f(ga);
                    r8[2 * e + 1] = (o[2 * e + 1] - mu) * rstd * gwv[2 * e + 1] * silu_f(gb);
                }
                bf16_t* mp = MX + row * DM + 512 + h * 128 + gdv0;
                *(u32x4*)mp = pack8(r8); *(u32x4*)(mp + 8) = pack8(r8 + 8);
            }
        }
    }
#undef RET_LOAD
    float* dst = p.out + (SAMPLE ? O_SS : O_SP) + (size_t)(b * 4 + h) * 16384;
#pragma unroll
    for (int t2 = 0; t2 < 2; ++t2)
#pragma unroll
        for (int r = 0; r < 16; ++r) { const int dk = (kt0 + t2) * 32 + (r & 3) + 8 * (r >> 2) + 4 * hh; dst[dk * 128 + ct * 32 + l31] = Sacc[t2][r]; }
    lds_barrier();
}

constexpr size_t WS_SC = 400 * MiB;
__device__ __forceinline__ void ret_chain(const Params& p, unsigned char* lds, int b, int h) {
    const bf16_t* Z = (const bf16_t*)(p.ws + WS_Z);
    const float* tcs = (const float*)(p.ws + WS_COS); const float* tsn = (const float*)(p.ws + WS_SIN);
    const int tid = opaque_tid(), w = tid >> 6, lane = tid & 63, l31 = lane & 31, hh = lane >> 5;
    const float lg = __logf(1.0f - exp2f(-5.0f - (float)h));
    const float gL = expf(lg * 64.0f);
    const int ct = w & 3, kt0 = (w >> 2) * 2;
    const int si = tid >> 3, sd0 = (tid & 7) * 8, srot = (tid & 7) * 8;
    const int sc = (si + srot) & 63;
    const float kd = __expf(-lg * (float)(si + 1)) * 0.08838834764831845f;
    u32x2* SC = (u32x2*)(p.ws + WS_SC) + (size_t)(b * 4 + h) * 32 * 4096;
    f32x16 Sacc[2];
#pragma unroll
    for (int t2 = 0; t2 < 2; ++t2)
#pragma unroll
        for (int r = 0; r < 16; ++r) Sacc[t2][r] = 0.f;
    u32x4 k1A, k2A, v1A, v2A, k1B, k2B, v1B, v2B; f32x4 c0A, c1A, s0A, s1A, c0B, c1B, s0B, s1B;
#define CH_LOAD(cc, X) do { \
        const size_t _row = (size_t)b * 2048 + (size_t)(cc) * 64 + si; const int _trow = (cc) * 64 + si; \
        const bf16_t* _zr = Z + _row * DIN; \
        k1##X = *(const u32x4*)(_zr + C_KR + h * 128 + sd0); k2##X = *(const u32x4*)(_zr + C_KR + h * 128 + 64 + sd0); \
        v1##X = *(const u32x4*)(_zr + C_VR + h * 128 + sd0); v2##X = *(const u32x4*)(_zr + C_VR + h * 128 + 64 + sd0); \
        c0##X = *(const f32x4*)(tcs + _trow * 64 + sd0); c1##X = *(const f32x4*)(tcs + _trow * 64 + sd0 + 4); \
        s0##X = *(const f32x4*)(tsn + _trow * 64 + sd0); s1##X = *(const f32x4*)(tsn + _trow * 64 + sd0 + 4); } while (0)
#define CH_STORE(bufi, X) do { \
        bf16_t* _Kt = (bf16_t*)(lds + (bufi) * 40960); bf16_t* _Vt = (bf16_t*)(lds + (bufi) * 40960 + 20480); \
        float ka[8], kb[8]; \
        _Pragma("unroll") for (int e = 0; e < 4; ++e) { const unsigned wk1 = k1##X[e], wk2 = k2##X[e]; \
            _Pragma("unroll") for (int hf = 0; hf < 2; ++hf) { const int ee = e * 2 + hf; \
                const float cs = ee < 4 ? c0##X[ee & 3] : c1##X[ee & 3], sn = ee < 4 ? s0##X[ee & 3] : s1##X[ee & 3]; \
                const float y1 = hf ? bf_hi(wk1) : bf_lo(wk1), y2 = hf ? bf_hi(wk2) : bf_lo(wk2); \
                ka[ee] = (y1 * cs - y2 * sn) * kd; kb[ee] = (y2 * cs + y1 * sn) * kd; } } \
        const u32x4 pka = pack8(ka), pkb = pack8(kb); \
        _Pragma("unroll") for (int e = 0; e < 4; ++e) { \
            _Kt[(sd0 + 2 * e) * LDT + sc] = (bf16_t)(pka[e] & 0xffffu); _Kt[(sd0 + 2 * e + 1) * LDT + sc] = (bf16_t)(pka[e] >> 16); \
            _Kt[(64 + sd0 + 2 * e) * LDT + sc] = (bf16_t)(pkb[e] & 0xffffu); _Kt[(64 + sd0 + 2 * e + 1) * LDT + sc] = (bf16_t)(pkb[e] >> 16); \
            _Vt[(sd0 + 2 * e) * LDT + sc] = (bf16_t)(v1##X[e] & 0xffffu); _Vt[(sd0 + 2 * e + 1) * LDT + sc] = (bf16_t)(v1##X[e] >> 16); \
            _Vt[(64 + sd0 + 2 * e) * LDT + sc] = (bf16_t)(v2##X[e] & 0xffffu); _Vt[(64 + sd0 + 2 * e + 1) * LDT + sc] = (bf16_t)(v2##X[e] >> 16); } } while (0)
#define CH_STEP(c, X) do { \
        lds_barrier(); \
        { u32x2* dst = SC + (size_t)(((c) + 31) & 31) * 4096 + (size_t)w * 512 + lane; \
          _Pragma("unroll") for (int t2 = 0; t2 < 2; ++t2) _Pragma("unroll") for (int g4 = 0; g4 < 4; ++g4) { \
              u32x2 wv; wv.x = cvt_pk(Sacc[t2][4 * g4 + 0], Sacc[t2][4 * g4 + 1]); wv.y = cvt_pk(Sacc[t2][4 * g4 + 2], Sacc[t2][4 * g4 + 3]); \
              dst[(t2 * 4 + g4) * 64] = wv; } } \
        CH_STORE(((c) + 1) & 1, X); \
        { const int cn = (c) + 3 < 32 ? (c) + 3 : 31; CH_LOAD(cn, X); } \
        asm volatile("" ::: "memory"); __builtin_amdgcn_sched_barrier(0); \
        { const bf16_t* Kt = (const bf16_t*)(lds + ((c) & 1) * 40960); const bf16_t* Vt = (const bf16_t*)(lds + ((c) & 1) * 40960 + 20480); \
          bf16x8 vf[4]; \
          _Pragma("unroll") for (int ks = 0; ks < 4; ++ks) vf[ks] = *(const bf16x8*)(Vt + (ct * 32 + l31) * LDT + ((ks * 16 + 8 * hh + 8 * (((ct * 32 + l31) >> 3) & 7)) & 63)); \
          _Pragma("unroll") for (int t2 = 0; t2 < 2; ++t2) { \
              _Pragma("unroll") for (int ks = 0; ks < 4; ++ks) { const bf16x8 af = *(const bf16x8*)(Kt + ((kt0 + t2) * 32 + l31) * LDT + ((ks * 16 + 8 * hh + 8 * ((((kt0 + t2) * 32 + l31) >> 3) & 7)) & 63)); Sacc[t2] = mfma32(af, vf[ks], Sacc[t2]); } \
              _Pragma("unroll") for (int r = 0; r < 16; ++r) Sacc[t2][r] *= gL; } } } while (0)
    CH_LOAD(0, A);
    CH_STORE(0, A);
    CH_LOAD(1, A);
    CH_LOAD(2, B);
    for (int c = 0; c < 32; c += 2) {
        CH_STEP(c, A);
        CH_STEP(c + 1, B);
    }
#undef CH_LOAD
#undef CH_STORE
#undef CH_STEP
    float* dst = p.out + O_SP + (size_t)(b * 4 + h) * 16384;
#pragma unroll
    for (int t2 = 0; t2 < 2; ++t2)
#pragma unroll
        for (int r = 0; r < 16; ++r) { const int dk = (kt0 + t2) * 32 + (r & 3) + 8 * (r >> 2) + 4 * hh; dst[dk * 128 + ct * 32 + l31] = Sacc[t2][r]; }
    lds_barrier();
}

__device__ __forceinline__ void ret_out_item(const Params& p, unsigned char* lds, int b, int h, int c) {
    bf16_t* Qs = (bf16_t*)(lds + R_QS); bf16_t* Ks = (bf16_t*)(lds + R_KS); bf16_t* Vt = (bf16_t*)(lds + R_VT);
    bf16_t* As = (bf16_t*)(lds + R_AS); bf16_t* St = (bf16_t*)(lds + R_ST); float* Ob = (float*)(lds + R_OB);
    const bf16_t* Z = (const bf16_t*)(p.ws + WS_Z);
    bf16_t* MX = (bf16_t*)(p.ws + WS_MIX);
    const float* tcs = (const float*)(p.ws + WS_COS); const float* tsn = (const float*)(p.ws + WS_SIN);
    const int tid = opaque_tid(), w = tid >> 6, lane = tid & 63, l31 = lane & 31, hh = lane >> 5;
    const float lg = __logf(1.0f - exp2f(-5.0f - (float)h));
    const int ct = w & 3, kt0 = (w >> 2) * 2, rt = w >> 2;
    const int si = tid >> 3, sd0 = (tid & 7) * 8, sc = (si + (tid & 7) * 8) & 63;
    const float qd = __expf(lg * (float)(si + 1)), kd = __expf(-lg * (float)(si + 1)) * 0.08838834764831845f;
    const int gi = tid >> 3, gdv0 = (tid & 7) * 16;
    const size_t row = (size_t)b * 2048 + (size_t)c * 64 + si; const int trow = c * 64 + si;
    const bf16_t* zr = Z + row * DIN;
    const u32x4 q1 = *(const u32x4*)(zr + C_QR + h * 128 + sd0), q2 = *(const u32x4*)(zr + C_QR + h * 128 + 64 + sd0);
    const u32x4 k1 = *(const u32x4*)(zr + C_KR + h * 128 + sd0), k2 = *(const u32x4*)(zr + C_KR + h * 128 + 64 + sd0);
    const u32x4 v1 = *(const u32x4*)(zr + C_VR + h * 128 + sd0), v2 = *(const u32x4*)(zr + C_VR + h * 128 + 64 + sd0);
    const f32x4 c0 = *(const f32x4*)(tcs + trow * 64 + sd0), c1 = *(const f32x4*)(tcs + trow * 64 + sd0 + 4);
    const f32x4 s0 = *(const f32x4*)(tsn + trow * 64 + sd0), s1 = *(const f32x4*)(tsn + trow * 64 + sd0 + 4);
    const size_t grow = (size_t)b * 2048 + (size_t)c * 64 + gi;
    const bf16_t* gp = Z + grow * DIN + C_GR + h * 128 + gdv0;
    const u32x4 gc1 = *(const u32x4*)gp, gc2 = *(const u32x4*)(gp + 8);
    u32x2 sfr[8];
    if (c > 0) {
        const u32x2* src = (const u32x2*)(p.ws + WS_SC) + ((size_t)(b * 4 + h) * 32 + (c - 1)) * 4096 + (size_t)w * 512 + lane;
#pragma unroll
        for (int f = 0; f < 8; ++f) sfr[f] = src[f * 64];
    } else {
#pragma unroll
        for (int f = 0; f < 8; ++f) sfr[f] = (u32x2){0u, 0u};
    }
    float gwv[16];
#pragma unroll
    for (int e4 = 0; e4 < 4; ++e4) { const f32x4 t4 = *(const f32x4*)(p.gn_w + h * 128 + gdv0 + e4 * 4); gwv[e4 * 4] = t4[0]; gwv[e4 * 4 + 1] = t4[1]; gwv[e4 * 4 + 2] = t4[2]; gwv[e4 * 4 + 3] = t4[3]; }
    {
        float qa[8], qb[8], ka[8], kb[8];
#pragma unroll
        for (int e = 0; e < 4; ++e) {
            const unsigned wq1 = q1[e], wq2 = q2[e], wk1 = k1[e], wk2 = k2[e];
#pragma unroll
            for (int hf = 0; hf < 2; ++hf) {
                const int ee = e * 2 + hf;
                const float cs = ee < 4 ? c0[ee & 3] : c1[ee & 3], sn = ee < 4 ? s0[ee & 3] : s1[ee & 3];
                const float x1 = hf ? bf_hi(wq1) : bf_lo(wq1), x2 = hf ? bf_hi(wq2) : bf_lo(wq2);
                const float y1 = hf ? bf_hi(wk1) : bf_lo(wk1), y2 = hf ? bf_hi(wk2) : bf_lo(wk2);
                qa[ee] = (x1 * cs - x2 * sn) * qd; qb[ee] = (x2 * cs + x1 * sn) * qd;
                ka[ee] = (y1 * cs - y2 * sn) * kd; kb[ee] = (y2 * cs + y1 * sn) * kd;
            }
        }
        *(u32x4*)(Qs + si * LDQ + sd0) = pack8(qa); *(u32x4*)(Qs + si * LDQ + 64 + sd0) = pack8(qb);
        *(u32x4*)(Ks + si * LDQ + sd0) = pack8(ka); *(u32x4*)(Ks + si * LDQ + 64 + sd0) = pack8(kb);
#pragma unroll
        for (int e = 0; e < 4; ++e) {
            Vt[(sd0 + 2 * e) * LDT + sc] = (bf16_t)(v1[e] & 0xffffu); Vt[(sd0 + 2 * e + 1) * LDT + sc] = (bf16_t)(v1[e] >> 16);
            Vt[(64 + sd0 + 2 * e) * LDT + sc] = (bf16_t)(v2[e] & 0xffffu); Vt[(64 + sd0 + 2 * e + 1) * LDT + sc] = (bf16_t)(v2[e] >> 16);
        }
#pragma unroll
        for (int t2 = 0; t2 < 2; ++t2)
#pragma unroll
            for (int g4 = 0; g4 < 4; ++g4) { const int dk0 = (kt0 + t2) * 32 + 8 * g4 + 4 * hh, dv = ct * 32 + l31; *(u32x2*)(St + dv * LDQ + dk0) = sfr[t2 * 4 + g4]; }
    }
    lds_barrier();
#pragma unroll
    for (int tq = 0; tq < 2; ++tq) {
        const int tt = w + tq * 8, jt = tt >> 2, it = tt & 3;
        f32x4 a4 = {0.f, 0.f, 0.f, 0.f};
        if (it >= jt) {
#pragma unroll
            for (int kk = 0; kk < 4; ++kk) {
                const bf16x8 af = *(const bf16x8*)(Ks + (jt * 16 + (lane & 15)) * LDQ + kk * 32 + (lane >> 4) * 8);
                const bf16x8 bfr = *(const bf16x8*)(Qs + (it * 16 + (lane & 15)) * LDQ + kk * 32 + (lane >> 4) * 8);
                a4 = mfma16(af, bfr, a4);
            }
        }
        const int i = it * 16 + (lane & 15), j0 = jt * 16 + 4 * (lane >> 4);
        u32x2 wv; wv.x = cvt_pk(i >= j0 ? a4[0] : 0.f, i >= j0 + 1 ? a4[1] : 0.f); wv.y = cvt_pk(i >= j0 + 2 ? a4[2] : 0.f, i >= j0 + 3 ? a4[3] : 0.f);
        *(u32x2*)(As + i * LDA + j0) = wv;
    }
    lds_barrier();
    {
        f32x16 O;
#pragma unroll
        for (int r = 0; r < 16; ++r) O[r] = 0.f;
#pragma unroll
        for (int ks = 0; ks < 4; ++ks) {
            const bf16x8 vfr = *(const bf16x8*)(Vt + (ct * 32 + l31) * LDT + ((ks * 16 + 8 * hh + 8 * (((ct * 32 + l31) >> 3) & 7)) & 63));
            const bf16x8 af = *(const bf16x8*)(As + (rt * 32 + l31) * LDA + ks * 16 + 8 * hh);
            O = mfma32(af, vfr, O);
        }
#pragma unroll
        for (int ks = 0; ks < 8; ++ks) {
            const bf16x8 af = *(const bf16x8*)(Qs + (rt * 32 + l31) * LDQ + ks * 16 + 8 * hh);
            const bf16x8 bfr = *(const bf16x8*)(St + (ct * 32 + l31) * LDQ + ks * 16 + 8 * hh);
            O = mfma32(af, bfr, O);
        }
#pragma unroll
        for (int r = 0; r < 16; ++r) { const int i = rt * 32 + (r & 3) + 8 * (r >> 2) + 4 * hh; Ob[i * LDO + ct * 32 + l31] = O[r]; }
    }
    lds_barrier();
    {
        float o[16];
#pragma unroll
        for (int e4 = 0; e4 < 4; ++e4) { const f32x4 v = *(const f32x4*)(Ob + gi * LDO + gdv0 + e4 * 4); o[e4 * 4] = v[0]; o[e4 * 4 + 1] = v[1]; o[e4 * 4 + 2] = v[2]; o[e4 * 4 + 3] = v[3]; }
        float sm = 0.f;
#pragma unroll
        for (int e = 0; e < 16; ++e) sm += o[e];
        sm += __shfl_xor(sm, 1); sm += __shfl_xor(sm, 2); sm += __shfl_xor(sm, 4);
        const float mu = sm * (1.0f / 128.0f);
        float q = 0.f;
#pragma unroll
        for (int e = 0; e < 16; ++e) { const float d = o[e] - mu; q += d * d; }
        q += __shfl_xor(q, 1); q += __shfl_xor(q, 2); q += __shfl_xor(q, 4);
        const float rstd = rsqrtf(q * (1.0f / 128.0f) + 1e-5f);
        float r8[16];
#pragma unroll
        for (int e = 0; e < 8; ++e) {
            const unsigned wg = e < 4 ? gc1[e & 3] : gc2[e & 3];
            r8[2 * e] = (o[2 * e] - mu) * rstd * gwv[2 * e] * silu_f(bf_lo(wg));
            r8[2 * e + 1] = (o[2 * e + 1] - mu) * rstd * gwv[2 * e + 1] * silu_f(bf_hi(wg));
        }
        bf16_t* mp = MX + grow * DM + 512 + h * 128 + gdv0;
        *(u32x4*)mp = pack8(r8); *(u32x4*)(mp + 8) = pack8(r8 + 8);
    }
    lds_barrier();
}

constexpr int W_KS = 0, W_VT = 36864;
constexpr int LDK = 72, LDV = 264;

template <bool SAMPLE>
__device__ __forceinline__ void swa_item(const Params& p, unsigned char* lds, int b, int blk, int kvh) {
    bf16_t* Ksw = (bf16_t*)(lds + W_KS); bf16_t* Vtw = (bf16_t*)(lds + W_VT);
    const bf16_t* Z = (const bf16_t*)(p.ws + WS_Z);
    bf16_t* MX = (bf16_t*)(p.ws + WS_MIX);
    const int tid = opaque_tid(), w = tid >> 6, lane = tid & 63, l31 = lane & 31, hh = lane >> 5;
    constexpr int NKEYS = SAMPLE ? 160 : 256;
    constexpr int NT = SAMPLE ? 1 : 2;
    bf16x8 Qf[4];
#define SWA_LOADQ(q2v) do { \
        const int _i0 = SAMPLE ? 0 : ((w & 1) * 2 + (q2v)) * 32; \
        const size_t _qrow = SAMPLE ? (size_t)NPROMPT + (size_t)b * 8 + (l31 & 7) : (size_t)b * 2048 + blk * 128 + _i0 + l31; \
        const int _head = SAMPLE ? kvh * 4 + (l31 >> 3) : kvh * 4 + (w >> 1); \
        _Pragma("unroll") for (int ks = 0; ks < 4; ++ks) Qf[ks] = *(const bf16x8*)(Z + _qrow * DIN + C_QA + _head * 64 + ks * 16 + 8 * hh); } while (0)
    SWA_LOADQ(0);
    for (int idx = tid; idx < NKEYS * 8; idx += 512) {
        const int j = idx >> 3, d0 = (idx & 7) * 8;
        u32x4 kq = {0u, 0u, 0u, 0u}, vq = {0u, 0u, 0u, 0u};
        if (!SAMPLE) {
            const int tk = blk * 128 - 128 + j;
            if (tk >= 0) { const bf16_t* zr = Z + ((size_t)b * 2048 + tk) * DIN; kq = *(const u32x4*)(zr + C_KA + kvh * 64 + d0); vq = *(const u32x4*)(zr + C_VA + kvh * 64 + d0); }
        } else {
            if (j < 128) {
                const float* ckp = p.ck + (((size_t)b * 128 + j) * 2 + kvh) * 64 + d0; const float* cvp = p.cv + (((size_t)b * 128 + j) * 2 + kvh) * 64 + d0;
                const f32x4 a0 = *(const f32x4*)ckp, a1 = *(const f32x4*)(ckp + 4), b0 = *(const f32x4*)cvp, b1 = *(const f32x4*)(cvp + 4);
                kq.x = cvt_pk(a0[0], a0[1]); kq.y = cvt_pk(a0[2], a0[3]); kq.z = cvt_pk(a1[0], a1[1]); kq.w = cvt_pk(a1[2], a1[3]);
                vq.x = cvt_pk(b0[0], b0[1]); vq.y = cvt_pk(b0[2], b0[3]); vq.z = cvt_pk(b1[0], b1[1]); vq.w = cvt_pk(b1[2], b1[3]);
            } else if (j < 136) {
                const bf16_t* zr = Z + ((size_t)NPROMPT + (size_t)b * 8 + (j - 128)) * DIN; kq = *(const u32x4*)(zr + C_KA + kvh * 64 + d0); vq = *(const u32x4*)(zr + C_VA + kvh * 64 + d0);
            }
        }
        *(u32x4*)(Ksw + j * LDK + d0) = kq;
        const int kk = j & 15, jp = (((j & ~15) | (((kk >> 2) & 1) << 3) | (((kk >> 3) & 1) << 2) | (kk & 3)) + d0) & 255;
#pragma unroll
        for (int e = 0; e < 4; ++e) { Vtw[(d0 + 2 * e) * LDV + jp] = (bf16_t)(vq[e] & 0xffffu); Vtw[(d0 + 2 * e + 1) * LDV + jp] = (bf16_t)(vq[e] >> 16); }
    }
    lds_barrier();
    if (!SAMPLE || w == 0) {
        const int g = w >> 1;
#pragma unroll 1
        for (int q2 = 0; q2 < NT; ++q2) {

            const int i0 = SAMPLE ? 0 : ((w & 1) * 2 + q2) * 32;
                        const int head = SAMPLE ? kvh * 4 + (l31 >> 3) : kvh * 4 + g;
            const int iq = SAMPLE ? (l31 & 7) : i0 + l31;
            const float sink = p.sinks[head];
            f32x16 S[5];
#pragma unroll
            for (int kt = 0; kt < 5; ++kt) {
#pragma unroll
                for (int r = 0; r < 16; ++r) S[kt][r] = 0.f;
#pragma unroll
                for (int ks = 0; ks < 4; ++ks) { const bf16x8 kf = *(const bf16x8*)(Ksw + (i0 + 32 * kt + l31) * LDK + ks * 16 + 8 * hh); S[kt] = mfma32(kf, Qf[ks], S[kt]); }
            }
            if (q2 + 1 < NT) SWA_LOADQ(q2 + 1);
            float m = sink;
#pragma unroll
            for (int kt = 0; kt < 5; ++kt)
#pragma unroll
                for (int r = 0; r < 16; ++r) {
                    const int j = i0 + 32 * kt + (r & 3) + 8 * (r >> 2) + 4 * hh;
                    const bool valid = (j >= iq) && (j <= iq + 128) && (SAMPLE || blk > 0 || j >= 128);
                    const float s = valid ? S[kt][r] * 0.125f : -1e30f;
                    S[kt][r] = s; m = fmaxf(m, s);
                }
            m = fmaxf(m, __shfl_xor(m, 32));
            float sum = 0.f;
#pragma unroll
            for (int kt = 0; kt < 5; ++kt)
#pragma unroll
                for (int r = 0; r < 16; ++r) { const float e = __expf(S[kt][r] - m); S[kt][r] = e; sum += e; }
            sum += __shfl_xor(sum, 32);
            const float inv = 1.0f / (sum + __expf(sink - m));
            bf16_t graw[2][16];
#pragma unroll
            for (int dt = 0; dt < 2; ++dt)
#pragma unroll
                for (int r = 0; r < 16; ++r) {
                    const int qc = (r & 3) + 8 * (r >> 2) + 4 * hh;
                    const size_t orow = SAMPLE ? (size_t)NPROMPT + (size_t)b * 8 + (qc & 7) : (size_t)b * 2048 + blk * 128 + i0 + qc;
                    const int col = (SAMPLE ? kvh * 4 + (qc >> 3) : kvh * 4 + g) * 64 + dt * 32 + l31;
                    graw[dt][r] = Z[orow * DIN + C_GA + col];
                }
            f32x16 O[2];
#pragma unroll
            for (int dt = 0; dt < 2; ++dt)
#pragma unroll
                for (int r = 0; r < 16; ++r) O[dt][r] = 0.f;
#pragma unroll
            for (int kt = 0; kt < 5; ++kt)
#pragma unroll
                for (int s2 = 0; s2 < 2; ++s2) {
                    u32x4 pw;
                    pw.x = cvt_pk(S[kt][8 * s2 + 0] * inv, S[kt][8 * s2 + 1] * inv); pw.y = cvt_pk(S[kt][8 * s2 + 2] * inv, S[kt][8 * s2 + 3] * inv);
                    pw.z = cvt_pk(S[kt][8 * s2 + 4] * inv, S[kt][8 * s2 + 5] * inv); pw.w = cvt_pk(S[kt][8 * s2 + 6] * inv, S[kt][8 * s2 + 7] * inv);
#pragma unroll
                    for (int dt = 0; dt < 2; ++dt) { const bf16x8 vfr = *(const bf16x8*)(Vtw + (dt * 32 + l31) * LDV + ((i0 + 32 * kt + 16 * s2 + 8 * hh + 8 * (((dt * 32 + l31) >> 3) & 7)) & 255)); O[dt] = mfma32(as_frag(pw), vfr, O[dt]); }
                }
#pragma unroll
            for (int dt = 0; dt < 2; ++dt)
#pragma unroll
                for (int r = 0; r < 16; ++r) {
                    const int qc = (r & 3) + 8 * (r >> 2) + 4 * hh;
                    const size_t orow = SAMPLE ? (size_t)NPROMPT + (size_t)b * 8 + (qc & 7) : (size_t)b * 2048 + blk * 128 + i0 + qc;
                    const int col = (SAMPLE ? kvh * 4 + (qc >> 3) : kvh * 4 + g) * 64 + dt * 32 + l31;
                    const float gv = __uint_as_float(((unsigned)graw[dt][r]) << 16);
                    MX[orow * DM + col] = (bf16_t)(cvt_pk(O[dt][r] * silu_f(gv), 0.f) & 0xffffu);
                }
        }
    }
    lds_barrier();
#undef SWA_LOADQ
}

__device__ __forceinline__ void p2a_mixers(const Params& p, unsigned char* lds) {
    const int G = gridDim.x, bx = blockIdx.x;
    const int NRET = 64;
    if (G > NRET) {
        if (bx < NRET) { ret_chain(p, lds, bx >> 2, bx & 3); return; }
    } else {
        for (int it = bx; it < NRET; it += G) ret_chain(p, lds, it >> 2, it & 3);
    }
    const int nb = G > NRET ? G - NRET : G, me = G > NRET ? bx - NRET : bx;
    for (int it = me; it < 512 + 512 + 256; it += nb) {
        if (it < 512) { swa_item<false>(p, lds, it >> 5, (it >> 1) & 15, it & 1); }
        else if (it < 1024) { const int s = it - 512; ret_item<true>(p, lds, s >> 2, s & 3); }
        else { const int s = it - 1024; swa_item<true>(p, lds, s >> 1, 0, s & 1); }
    }
}
__device__ __forceinline__ void p2b_ret_out(const Params& p, unsigned char* lds) {
    for (int it = blockIdx.x; it < 2048; it += gridDim.x) ret_out_item(p, lds, it >> 7, (it >> 5) & 3, it & 31);
}

__global__ void __launch_bounds__(512) hymba_fwd(Params p) {
    extern __shared__ __attribute__((aligned(16))) unsigned char lds[];
    cg::grid_group grid = cg::this_grid();
    p0_prologue(p, lds);
    grid.sync();
    p1a_modulate(p);
    grid.sync();
    {
        pg8::Gemm g{(const pg8::bf16_t*)(p.ws + WS_H), (const pg8::bf16_t*)(p.ws + WS_WIN), MROWS, DIN, DM};
        pg8::StaticOrder S; S.init(MROWS, DIN, (int)gridDim.x, (int)blockIdx.x);
        EpiZ E{(bf16_t*)(p.ws + WS_Z), p.out};
        pg8::gemm_phase<EpiZ, pg8::StaticOrder>((PG8_LAS unsigned char*)lds, g, S, E);
    }
    grid.sync();
    p2a_mixers(p, lds);
    grid.sync();
    p2b_ret_out(p, lds);
    grid.sync();
    {
        pg8::Gemm g{(const pg8::bf16_t*)(p.ws + WS_MIX), (const pg8::bf16_t*)(p.ws + WS_WOUT), MROWS, DM, DM};
        pg8::StaticOrder S; S.init(MROWS, DM, (int)gridDim.x, (int)blockIdx.x);
        EpiY E{(bf16_t*)(p.ws + WS_Y)};
        pg8::gemm_phase<EpiY, pg8::StaticOrder>((PG8_LAS unsigned char*)lds, g, S, E);
    }
    grid.sync();
    p4_layernorm(p);
}

extern "C" void kernel_launch(void* const* d_in, const int* in_sizes, int n_in, void* d_out, int out_size, void* d_ws, size_t ws_size, hipStream_t stream) {
    static int grid_blocks = 0;
    if (!grid_blocks) {
        int dev = 0, cus = 0, per_cu = 0;
        hipGetDevice(&dev);
        hipDeviceGetAttribute(&cus, hipDeviceAttributeMultiprocessorCount, dev);
        hipFuncSetAttribute((const void*)hymba_fwd, hipFuncAttributeMaxDynamicSharedMemorySize, LDS_BYTES);
        hipOccupancyMaxActiveBlocksPerMultiprocessor(&per_cu, (const void*)hymba_fwd, 512, LDS_BYTES);
        if (per_cu < 1) { fprintf(stderr, "kernel_launch: occupancy query reports %d blocks per CU\n", per_cu); per_cu = 1; }
        grid_blocks = cus * per_cu;
        if (grid_blocks > 256) grid_blocks = 256;
    }
    Params p{};
    p.xp = (const float*)d_in[0]; p.xs = (const float*)d_in[1]; p.cp = (const float*)d_in[2]; p.cs = (const float*)d_in[3];
    p.ck = (const float*)d_in[4]; p.cv = (const float*)d_in[5]; p.st = (const float*)d_in[6];
    p.w_ada = (const float*)d_in[7]; p.b_ada = (const float*)d_in[8]; p.w_in = (const float*)d_in[9]; p.sinks = (const float*)d_in[10];
    p.gn_w = (const float*)d_in[11]; p.w_out = (const float*)d_in[12]; p.ln_w = (const float*)d_in[13]; p.ln_b = (const float*)d_in[14];
    p.out = (float*)d_out; p.ws = (unsigned char*)d_ws;
    void* args[] = {&p};
    hipError_t e = hipLaunchCooperativeKernel((const void*)hymba_fwd, dim3(grid_blocks), dim3(512), args, LDS_BYTES, stream);
    if (e != hipSuccess) fprintf(stderr, "cooperative launch failed: %s (grid %d)\n", hipGetErrorString(e), grid_blocks);
}
```

```cpp
#include <hip/hip_runtime.h>
#include <hip/hip_cooperative_groups.h>
#include <cstdio>
namespace cg = cooperative_groups;
__device__ __forceinline__ void lds_barrier() { asm volatile("s_waitcnt lgkmcnt(0)" ::: "memory"); __builtin_amdgcn_s_barrier(); asm volatile("" ::: "memory"); }
__device__ __forceinline__ void fast_grid_barrier(unsigned* bar, unsigned seam) {
    __syncthreads();
    if (threadIdx.x == 0) {
        __builtin_amdgcn_fence(__ATOMIC_RELEASE, "agent");
        __hip_atomic_fetch_add(bar, 1u, __ATOMIC_RELAXED, __HIP_MEMORY_SCOPE_AGENT);
        const unsigned target = seam * gridDim.x;
        while (__hip_atomic_load(bar, __ATOMIC_RELAXED, __HIP_MEMORY_SCOPE_AGENT) < target) __builtin_amdgcn_s_sleep(2);
        __builtin_amdgcn_fence(__ATOMIC_ACQUIRE, "agent");
    }
    __syncthreads();
}
__device__ __forceinline__ int opaque_tid() { int t = threadIdx.x; asm volatile("" : "+v"(t)); return t; }
namespace pg8 {
#define PG8_LAS __attribute__((address_space(3)))
typedef unsigned short bf16_t;
typedef short bf16x8 __attribute__((ext_vector_type(8)));
typedef float f32x4 __attribute__((ext_vector_type(4)));
typedef unsigned u32x4 __attribute__((ext_vector_type(4)));
constexpr int BM = 256, BK = 64, HALF = 128, HTB = HALF * BK * 2  , STAGE_BYTES = 8 * HTB, NXCD = 8, WGM = 8;

__host__ __device__ __forceinline__ int lds_byte(int r, int c) { const int st = (r >> 4) * 2 + (c >> 5), rr = r & 15, cc = c & 31, ob = rr * 64 + cc * 2; return st * 1024 + (ob ^ (((ob >> 9) & 1) << 5)); }
__host__ __device__ __forceinline__ void stage_rc(int b, int& R, int& C) { const int st = b / 1024, sb = b % 1024, swz = sb ^ (((sb >> 9) & 1) << 5); R = (st >> 1) * 16 + swz / 64; C = (st & 1) * 32 + (swz % 64) / 2; }
__host__ __device__ __forceinline__ int perm32(int rho) { const int n = rho >> 4, i = rho & 15; return 8 * (i >> 2) + 4 * n + (i & 3); }

struct Unit { int pm, pn; };
struct Gemm { const bf16_t* A; const bf16_t* Bt; int M, N, K; };

struct StaticOrder {
    int nM, nN, nwg, G, c;
    __host__ __device__ void init(int M, int N, int G_, int c_) { nM = M / BM; nN = N / BM; nwg = nM * nN; G = G_; c = c_; }
    __host__ __device__ bool next(int i, Unit& u) const {
        const long L = (long)i * G + c; if (L >= nwg) return false;
        int wgid = (int)L; { const int q = nwg / NXCD, r = nwg % NXCD, xcd = wgid % NXCD, off = wgid / NXCD; wgid = (xcd < r ? xcd * (q + 1) : r * (q + 1) + (xcd - r) * q) + off; }
        const int nig = WGM * nN, gid = wgid / nig, fm = gid * WGM, gsz = (nM - fm) < WGM ? (nM - fm) : WGM;
        u.pm = fm + ((wgid % nig) % gsz); u.pn = (wgid % nig) / gsz; return true;
    }
    __device__ __forceinline__ void a_ready(const Unit&) const {}
    __device__ __forceinline__ void done(const Unit&) const {}
};
__device__ __forceinline__ unsigned cvt_pk_bf16(float lo, float hi) { unsigned r; asm volatile("v_cvt_pk_bf16_f32 %0, %1, %2" : "=v"(r) : "v"(lo), "v"(hi)); return r; }
template <class Epi, class Sched>
__device__ __forceinline__ void gemm_phase(PG8_LAS unsigned char* lds, const Gemm g, const Sched& S, const Epi& E) {
    const int tid = opaque_tid(), wid = __builtin_amdgcn_readfirstlane(tid >> 6), lane = tid & 63, wr = wid >> 2, wc = wid & 3, fr = lane & 15, fq = lane >> 4;
    const int K = g.K, nt = K / BK;
    unsigned voffA[2], voffB[2];
#pragma unroll
    for (int i = 0; i < 2; ++i) { int R, C; stage_rc(tid * 16 + i * 8192, R, C); const int Rb = Epi::PERM ? ((R & ~31) + perm32(R & 31)) : R;
        voffA[i] = (unsigned)(R * K + C) * 2u; voffB[i] = (unsigned)(Rb * K + C) * 2u; }
    const size_t kstep = (size_t)(BK * 2);
    const size_t hstep = (size_t)HALF * K * 2;
    const size_t tstep = 2 * hstep;
    const unsigned ldsw = (unsigned)wid * 1024u;
    const int aoff = lds_byte(wr * 64 + fr, fq * 8), boff = lds_byte(wc * 32 + fr, fq * 8);
#define PG8_SA(b, h) (((b) * 2 + (h)) * HTB)
#define PG8_SB(b, h) ((4 + (b) * 2 + (h)) * HTB)
#define PG8_STAGE(bufoff, gbase, voff) do { _Pragma("unroll") for (int _i = 0; _i < 2; ++_i) \
        __builtin_amdgcn_global_load_lds((const unsigned*)((const char*)(gbase) + (voff)[_i]), (PG8_LAS unsigned*)(lds + (bufoff) + ldsw + _i * 8192), 16, 0, 0); } while (0)
#define PG8_LDA(dst, b, h) do { _Pragma("unroll") for (int m = 0; m < 4; ++m) _Pragma("unroll") for (int k = 0; k < 2; ++k) dst[m][k] = *(const PG8_LAS bf16x8*)(lds + PG8_SA(b, h) + aoff + m * 2048 + k * 1024); } while (0)
#define PG8_LDB(dst, b, h) do { _Pragma("unroll") for (int n = 0; n < 2; ++n) _Pragma("unroll") for (int k = 0; k < 2; ++k) dst[n][k] = *(const PG8_LAS bf16x8*)(lds + PG8_SB(b, h) + boff + n * 2048 + k * 1024); } while (0)
#define PG8_MMA(ai, bj, At, Bt) do { __builtin_amdgcn_s_setprio(1); _Pragma("unroll") for (int m = 0; m < 4; ++m) _Pragma("unroll") for (int n = 0; n < 2; ++n) _Pragma("unroll") for (int k = 0; k < 2; ++k) \
        acc[ai][bj][m][n] = __builtin_amdgcn_mfma_f32_16x16x32_bf16(Bt[n][k], At[m][k], acc[ai][bj][m][n], 0, 0, 0); __builtin_amdgcn_s_setprio(0); } while (0)
#define PG8_WAIT_V(n) asm volatile("s_waitcnt vmcnt(" #n ")" ::: "memory")
#define PG8_WAIT_L(n) asm volatile("s_waitcnt lgkmcnt(" #n ")" ::: "memory")
#define PG8_BAR __builtin_amdgcn_s_barrier()
#define PG8_SCHED __builtin_amdgcn_sched_barrier(0)
    Unit cur, nxt; int ui = 0;
    if (!S.next(0, cur)) return;
    f32x4 acc[2][2][4][2];
#pragma unroll
    for (int a = 0; a < 2; ++a)
#pragma unroll
        for (int b = 0; b < 2; ++b)
#pragma unroll
            for (int m = 0; m < 4; ++m)
#pragma unroll
                for (int n = 0; n < 2; ++n) acc[a][b][m][n] = (f32x4){0.f, 0.f, 0.f, 0.f};
    bf16x8 At[4][2], B0[2][2], B1[2][2];
    const char* cA = (const char*)g.A + (size_t)cur.pm * tstep; const char* cB = (const char*)g.Bt + (size_t)cur.pn * tstep;
    S.a_ready(cur);
    PG8_STAGE(PG8_SB(0, 0), cB, voffB); PG8_STAGE(PG8_SA(0, 0), cA, voffA); PG8_STAGE(PG8_SB(0, 1), cB + hstep, voffB); PG8_STAGE(PG8_SA(0, 1), cA + hstep, voffA);
    if (wr == 1) PG8_BAR;
    PG8_WAIT_V(4); PG8_BAR;
    PG8_STAGE(PG8_SB(1, 0), cB + kstep, voffB); PG8_STAGE(PG8_SA(1, 0), cA + kstep, voffA); PG8_STAGE(PG8_SB(1, 1), cB + hstep + kstep, voffB);
    PG8_WAIT_V(6); PG8_BAR;
    for (;;) {
        const bool has_next = S.next(ui + 1, nxt);
        const char* nA = has_next ? (const char*)g.A + (size_t)nxt.pm * tstep : cA; const char* nB = has_next ? (const char*)g.Bt + (size_t)nxt.pn * tstep : cB;
        for (int t = 0; t < nt; t += 2) {
            const bool last = (t == nt - 2);
            const char* a1 = cA + (size_t)(t + 1) * kstep;
            const char* a2 = last ? nA : cA + (size_t)(t + 2) * kstep; const char* b2 = last ? nB : cB + (size_t)(t + 2) * kstep;
            const char* a3 = a2 + kstep; const char* b3 = b2 + kstep;
            if (last && has_next) S.a_ready(nxt);
            PG8_LDB(B0, 0, 0); PG8_SCHED; PG8_LDA(At, 0, 0); PG8_STAGE(PG8_SA(1, 1), a1 + hstep, voffA);
            PG8_WAIT_L(8); PG8_BAR; PG8_WAIT_L(0); PG8_MMA(0, 0, At, B0); PG8_BAR; PG8_SCHED;
            PG8_LDB(B1, 0, 1); PG8_STAGE(PG8_SB(0, 0), b2, voffB);
            PG8_BAR; PG8_WAIT_L(0); PG8_MMA(0, 1, At, B1); PG8_BAR;
            PG8_LDA(At, 0, 1); PG8_STAGE(PG8_SA(0, 0), a2, voffA);
            PG8_BAR; PG8_WAIT_L(0); PG8_MMA(1, 0, At, B0); PG8_BAR; PG8_SCHED;
            PG8_STAGE(PG8_SB(0, 1), b2 + hstep, voffB);
            PG8_WAIT_V(6); PG8_BAR; PG8_MMA(1, 1, At, B1); PG8_BAR;
            PG8_LDB(B0, 1, 0); PG8_SCHED; PG8_LDA(At, 1, 0); PG8_STAGE(PG8_SA(0, 1), a2 + hstep, voffA);
            PG8_WAIT_L(8); PG8_BAR; PG8_WAIT_L(0); PG8_MMA(0, 0, At, B0); PG8_BAR; PG8_SCHED;
            PG8_LDB(B1, 1, 1); PG8_STAGE(PG8_SB(1, 0), b3, voffB);
            PG8_BAR; PG8_WAIT_L(0); PG8_MMA(0, 1, At, B1); PG8_BAR;
            PG8_LDA(At, 1, 1); PG8_STAGE(PG8_SA(1, 0), a3, voffA);
            PG8_BAR; PG8_WAIT_L(0); PG8_MMA(1, 0, At, B0); PG8_BAR; PG8_SCHED;
            PG8_STAGE(PG8_SB(1, 1), b3 + hstep, voffB);
            PG8_WAIT_V(6); PG8_BAR; PG8_MMA(1, 1, At, B1); PG8_BAR;
        }
        if constexpr (!Epi::AFTER_DRAIN) { E(acc, cur, wr, wc, fr, fq); S.done(cur); }
        if (!has_next) break;
#pragma unroll
        for (int a = 0; a < 2; ++a)
#pragma unroll
            for (int b = 0; b < 2; ++b)
#pragma unroll
                for (int m = 0; m < 4; ++m)
#pragma unroll
                    for (int n = 0; n < 2; ++n) acc[a][b][m][n] = (f32x4){0.f, 0.f, 0.f, 0.f};
        cur = nxt; cA = nA; cB = nB; ++ui;
    }
    PG8_WAIT_V(0);
    if (wr == 0) PG8_BAR;
    PG8_BAR;
    if constexpr (Epi::AFTER_DRAIN) { E.fused(acc, cur, wr, wc, fr, fq, lds, wid, lane); S.done(cur); }
#undef PG8_SA
#undef PG8_SB
#undef PG8_STAGE
#undef PG8_LDA
#undef PG8_LDB
#undef PG8_MMA
#undef PG8_WAIT_V
#undef PG8_WAIT_L
#undef PG8_BAR
#undef PG8_SCHED
}
}

typedef unsigned short bf16_t;
typedef short bf16x8 __attribute__((ext_vector_type(8)));
typedef float f32x4 __attribute__((ext_vector_type(4)));
typedef float f32x16 __attribute__((ext_vector_type(16)));
typedef unsigned u32x4 __attribute__((ext_vector_type(4)));
typedef unsigned u32x2 __attribute__((ext_vector_type(2)));

constexpr int DM = 1024, NPROMPT = 32768, NSAMPLE = 1024, MROWS = NPROMPT + NSAMPLE, DIN = 3328;
constexpr int C_QA = 0, C_KA = 512, C_VA = 640, C_GA = 768, C_QR = 1280, C_KR = 1792, C_VR = 2304, C_GR = 2816;
constexpr float ALPHA = 1.189207115002721f;
constexpr size_t O_Y = 0, O_KWP = 34603008, O_VWP = 34865152, O_SP = 35127296, O_KWS = 36175872, O_VWS = 38273024, O_SS = 40370176;
constexpr size_t MiB = 1u << 20;
constexpr size_t WS_WIN = 0, WS_WOUT = 8 * MiB, WS_COND = 12 * MiB, WS_COS = 16 * MiB, WS_SIN = 17 * MiB, WS_STATS = 20 * MiB, WS_BAR = 24 * MiB,
                 WS_H = 32 * MiB, WS_Y = 32 * MiB, WS_MIX = 100 * MiB, WS_Z = 168 * MiB;
constexpr int LDS_BYTES = 155648;

struct Params {
    const float* xp; const float* xs; const float* cp; const float* cs; const float* ck; const float* cv; const float* st;
    const float* w_ada; const float* b_ada; const float* w_in; const float* sinks; const float* gn_w; const float* w_out; const float* ln_w; const float* ln_b;
    float* out; unsigned char* ws;
};

__device__ __forceinline__ unsigned cvt_pk(float lo, float hi) { return pg8::cvt_pk_bf16(lo, hi); }
__device__ __forceinline__ float bf_lo(unsigned w) { return __uint_as_float(w << 16); }
__device__ __forceinline__ float bf_hi(unsigned w) { return __uint_as_float(w & 0xffff0000u); }
__device__ __forceinline__ float silu_f(float v) { return v * __builtin_amdgcn_rcpf(1.0f + __expf(-v)); }
__device__ __forceinline__ f32x16 mfma32(bf16x8 a, bf16x8 b, f32x16 c) { return __builtin_amdgcn_mfma_f32_32x32x16_bf16(a, b, c, 0, 0, 0); }
__device__ __forceinline__ f32x4 mfma16(bf16x8 a, bf16x8 b, f32x4 c) { return __builtin_amdgcn_mfma_f32_16x16x32_bf16(a, b, c, 0, 0, 0); }
__device__ __forceinline__ bf16x8 as_frag(u32x4 v) { return __builtin_bit_cast(bf16x8, v); }
__device__ __forceinline__ u32x4 pack8(const float* v) { u32x4 r; r.x = cvt_pk(v[0], v[1]); r.y = cvt_pk(v[2], v[3]); r.z = cvt_pk(v[4], v[5]); r.w = cvt_pk(v[6], v[7]); return r; }

struct EpiZ {
    static constexpr bool PERM = true, AFTER_DRAIN = false;
    bf16_t* Z; float* out;
    __device__ __forceinline__ void operator()(const f32x4 (&acc)[2][2][4][2], const pg8::Unit& u, int wr, int wc, int fr, int fq) const {
        const int row0 = u.pm * 256 + wr * 64 + fr, col0 = u.pn * 256 + wc * 32 + 8 * fq;
#pragma unroll
        for (int ai = 0; ai < 2; ++ai)
#pragma unroll
            for (int m = 0; m < 4; ++m) {
                const int row = row0 + ai * 128 + m * 16;
                bf16_t* rowp = Z + (size_t)row * DIN + col0;
#pragma unroll
                for (int bj = 0; bj < 2; ++bj) {
                    const f32x4 v0 = acc[ai][bj][m][0], v1 = acc[ai][bj][m][1];
                    u32x4 w; w.x = cvt_pk(v0[0], v0[1]); w.y = cvt_pk(v0[2], v0[3]); w.z = cvt_pk(v1[0], v1[1]); w.w = cvt_pk(v1[2], v1[3]);
                    *(u32x4*)(rowp + bj * 128) = w;
                }
                if (u.pn == 2) {
                    long base = -1;
                    size_t vofs = 0;
                    if (row < NPROMPT) { const int b = row >> 11, t = row & 2047; if (t >= 1920) { base = (long)O_KWP + (long)b * 16384 + (long)(t - 1920) * 128; vofs = O_VWP - O_KWP; } }
                    else { const int sr = row - NPROMPT, b = sr >> 3, t = sr & 7; base = (long)O_KWS + (long)b * 16384 + (long)(120 + t) * 128; vofs = O_VWS - O_KWS; }
                    if (base >= 0) {
                        const int cl = wc * 32 + 8 * fq;
#pragma unroll
                        for (int bj = 0; bj < 2; ++bj) {
                            float* dst = out + base + (bj ? vofs : 0) + cl;
                            *(f32x4*)dst = acc[ai][bj][m][0]; *(f32x4*)(dst + 4) = acc[ai][bj][m][1];
                        }
                    }
                }
            }
    }
};
struct EpiY {
    static constexpr bool PERM = true, AFTER_DRAIN = false;
    bf16_t* Y;
    __device__ __forceinline__ void operator()(const f32x4 (&acc)[2][2][4][2], const pg8::Unit& u, int wr, int wc, int fr, int fq) const {
        const int row0 = u.pm * 256 + wr * 64 + fr, col0 = u.pn * 256 + wc * 32 + 8 * fq;
#pragma unroll
        for (int ai = 0; ai < 2; ++ai)
#pragma unroll
            for (int m = 0; m < 4; ++m) {
                bf16_t* rowp = Y + (size_t)(row0 + ai * 128 + m * 16) * DM + col0;
#pragma unroll
                for (int bj = 0; bj < 2; ++bj) {
                    const f32x4 v0 = acc[ai][bj][m][0], v1 = acc[ai][bj][m][1];
                    u32x4 w; w.x = cvt_pk(v0[0], v0[1]); w.y = cvt_pk(v0[2], v0[3]); w.z = cvt_pk(v1[0], v1[1]); w.w = cvt_pk(v1[2], v1[3]);
                    *(u32x4*)(rowp + bj * 128) = w;
                }
            }
    }
};

__device__ __forceinline__ void p0_cond(const Params& p, unsigned char* lds, int nblk) {
    bf16_t* Bs = (bf16_t*)lds;
    const int tid = opaque_tid(), w = tid >> 6, lane = tid & 63, n0 = nblk * 16;
    float* cond = (float*)(p.ws + WS_COND);
    {
        float wv[32];
#pragma unroll
        for (int it = 0; it < 32; ++it) { const int idx = tid + it * 512; wv[it] = p.w_ada[(size_t)(idx >> 4) * 3072 + n0 + (idx & 15)]; }
#pragma unroll
        for (int it = 0; it < 32; ++it) { const int idx = tid + it * 512; Bs[(idx & 15) * 1032 + (idx >> 4)] = (bf16_t)(cvt_pk(wv[it], 0.f) & 0xffffu); }
    }
    __syncthreads();
    {
        f32x4 acc[9];
#pragma unroll
        for (int rt = 0; rt < 9; ++rt) acc[rt] = (f32x4){0.f, 0.f, 0.f, 0.f};
#pragma unroll
        for (int ks = 0; ks < 4; ++ks) {
            const int k0 = w * 128 + ks * 32 + (lane >> 4) * 8;
            const bf16x8 bfr = *(const bf16x8*)(Bs + (lane & 15) * 1032 + k0);
#pragma unroll
            for (int rt = 0; rt < 9; ++rt) {
                const float* crow = rt == 0 ? p.cp + (size_t)(lane & 15) * DM : p.cs + (size_t)((rt - 1) * 16 + (lane & 15)) * DM;
                const f32x4 a0 = *(const f32x4*)(crow + k0), a1 = *(const f32x4*)(crow + k0 + 4);
                u32x4 av; av.x = cvt_pk(silu_f(a0[0]), silu_f(a0[1])); av.y = cvt_pk(silu_f(a0[2]), silu_f(a0[3])); av.z = cvt_pk(silu_f(a1[0]), silu_f(a1[1])); av.w = cvt_pk(silu_f(a1[2]), silu_f(a1[3]));
                acc[rt] = mfma16(as_frag(av), bfr, acc[rt]);
            }
        }
        f32x4* part = (f32x4*)(lds + 40960);
#pragma unroll
        for (int rt = 0; rt < 9; ++rt) part[(w * 9 + rt) * 64 + lane] = acc[rt];
        __syncthreads();
        for (int t = tid; t < 576; t += 512) {
            const int rt = t >> 6, l = t & 63;
            f32x4 sum = {0.f, 0.f, 0.f, 0.f};
#pragma unroll
            for (int w2 = 0; w2 < 8; ++w2) sum += part[(w2 * 9 + rt) * 64 + l];
            const int n = n0 + (l & 15);
            const float bias = p.b_ada[n];
#pragma unroll
            for (int j = 0; j < 4; ++j) { const int r = rt * 16 + (l >> 4) * 4 + j; cond[(size_t)r * 3072 + n] = sum[j] + bias; }
        }
    }
    __syncthreads();
}
__device__ __forceinline__ void p0_transpose(const float* W, bf16_t* Wt, int K, int N, int tile, unsigned char* lds) {
    float* T = (float*)lds;
    const int tid = opaque_tid(), tiles_n = N / 64, kt = tile / tiles_n, nt = tile % tiles_n;
    for (int idx = tid; idx < 4096; idx += 512) { const int k = idx >> 6, n = idx & 63; T[k * 65 + n] = W[(size_t)(kt * 64 + k) * N + nt * 64 + n]; }
    __syncthreads();
    for (int idx = tid; idx < 2048; idx += 512) { const int n = idx >> 5, k = (idx & 31) * 2;
        *(unsigned*)(Wt + (size_t)(nt * 64 + n) * K + kt * 64 + k) = cvt_pk(T[k * 65 + n], T[(k + 1) * 65 + n]); }
    __syncthreads();
}
__device__ __forceinline__ void p0_prologue(const Params& p, unsigned char* lds) {
    const int tid = opaque_tid(), G = gridDim.x, bx = blockIdx.x;
    for (int nb = bx; nb < 192; nb += G) p0_cond(p, lds, nb);
    for (int t = (G - 1 - bx); t < 832 + 256; t += G) {
        if (t < 832) p0_transpose(p.w_in, (bf16_t*)(p.ws + WS_WIN), 1024, DIN, t, lds);
        else p0_transpose(p.w_out, (bf16_t*)(p.ws + WS_WOUT), 1024, 1024, t - 832, lds);
    }
    float* tc = (float*)(p.ws + WS_COS); float* tsn = (float*)(p.ws + WS_SIN);
    for (int idx = bx * 512 + tid; idx < 2056 * 64; idx += G * 512) {
        const int r = idx >> 6, d = idx & 63;
        const float pos = (float)(r < 2048 ? r : 16384 + (r - 2048));
        const float inv = powf(10000.0f, -(float)d / 64.0f);
        const float ang = pos * inv;
        const double a = (double)ang;
        const double nrev = rint(a * 0.15915494309189535);
        const float red = (float)(a - nrev * 6.283185307179586);
        tc[idx] = __cosf(red); tsn[idx] = __sinf(red);
    }
    for (int idx = bx * 512 + tid; idx < 128 * 3840; idx += G * 512) {
        const int b = idx / 3840, e = (idx % 3840) * 4;
        *(f32x4*)(p.out + O_KWS + (size_t)b * 16384 + e) = *(const f32x4*)(p.ck + (size_t)b * 16384 + 1024 + e);
        *(f32x4*)(p.out + O_VWS + (size_t)b * 16384 + e) = *(const f32x4*)(p.cv + (size_t)b * 16384 + 1024 + e);
    }
}
__device__ __forceinline__ void p1a_modulate(const Params& p) {
    const float* cond = (const float*)(p.ws + WS_COND);
    bf16_t* H = (bf16_t*)(p.ws + WS_H);
    for (size_t it = (size_t)blockIdx.x * 512 + threadIdx.x; it < (size_t)MROWS * 128; it += (size_t)gridDim.x * 512) {
        const int row = (int)(it >> 7), c8 = (int)(it & 127) * 8;
        const float* xr = row < NPROMPT ? p.xp + (size_t)row * DM : p.xs + (size_t)(row - NPROMPT) * DM;
        const int crow = row < NPROMPT ? (row >> 11) : 16 + ((row - NPROMPT) >> 3);
        const float* cr = cond + (size_t)crow * 3072;
        const f32x4 x0 = *(const f32x4*)(xr + c8), x1 = *(const f32x4*)(xr + c8 + 4);
        const f32x4 sh0 = *(const f32x4*)(cr + c8), sh1 = *(const f32x4*)(cr + c8 + 4);
        const f32x4 sc0 = *(const f32x4*)(cr + 1024 + c8), sc1 = *(const f32x4*)(cr + 1024 + c8 + 4);
        const f32x4 h0 = x0 * (sc0 + 1.0f) + sh0, h1 = x1 * (sc1 + 1.0f) + sh1;
        u32x4 w; w.x = cvt_pk(h0[0], h0[1]); w.y = cvt_pk(h0[2], h0[3]); w.z = cvt_pk(h1[0], h1[1]); w.w = cvt_pk(h1[2], h1[3]);
        *(u32x4*)(H + (size_t)row * DM + c8) = w;
    }
}
__device__ __forceinline__ void p4_layernorm(const Params& p) {
    const float* cond = (const float*)(p.ws + WS_COND);
    const bf16_t* Y = (const bf16_t*)(p.ws + WS_Y);
    const int w = threadIdx.x >> 6, lane = threadIdx.x & 63;
    for (int row0 = (blockIdx.x * 8 + w) * 2; row0 < MROWS; row0 += gridDim.x * 16) {
        f32x4 r[2][4];
#pragma unroll
        for (int rr = 0; rr < 2; ++rr) {
            const int row = row0 + rr;
            const float* xr = row < NPROMPT ? p.xp + (size_t)row * DM : p.xs + (size_t)(row - NPROMPT) * DM;
            const int crow = row < NPROMPT ? (row >> 11) : 16 + ((row - NPROMPT) >> 3);
            const float* gr = cond + (size_t)crow * 3072 + 2048;
            const bf16_t* yr = Y + (size_t)row * DM;
#pragma unroll
            for (int i = 0; i < 4; ++i) {
                const int c = (i * 64 + lane) * 4;
                const f32x4 xv = *(const f32x4*)(xr + c), gv = *(const f32x4*)(gr + c);
                const u32x2 yw = *(const u32x2*)(yr + c);
                f32x4 yv; yv[0] = bf_lo(yw.x); yv[1] = bf_hi(yw.x); yv[2] = bf_lo(yw.y); yv[3] = bf_hi(yw.y);
                r[rr][i] = xv * ALPHA + gv * yv;
            }
        }
#pragma unroll
        for (int rr = 0; rr < 2; ++rr) {
            float s = 0.f;
#pragma unroll
            for (int i = 0; i < 4; ++i) s += (r[rr][i][0] + r[rr][i][1]) + (r[rr][i][2] + r[rr][i][3]);
#pragma unroll
            for (int o = 1; o < 64; o <<= 1) s += __shfl_xor(s, o);
            const float mu = s * (1.0f / 1024.0f);
            float q = 0.f;
#pragma unroll
            for (int i = 0; i < 4; ++i) { const f32x4 d = r[rr][i] - mu; q += (d[0] * d[0] + d[1] * d[1]) + (d[2] * d[2] + d[3] * d[3]); }
#pragma unroll
            for (int o = 1; o < 64; o <<= 1) q += __shfl_xor(q, o);
            const float rstd = rsqrtf(q * (1.0f / 1024.0f) + 1e-5f);
            float* o = p.out + (size_t)(row0 + rr) * DM;
#pragma unroll
            for (int i = 0; i < 4; ++i) {
                const int c = (i * 64 + lane) * 4;
                const f32x4 lw = *(const f32x4*)(p.ln_w + c), lb = *(const f32x4*)(p.ln_b + c);
                *(f32x4*)(o + c) = (r[rr][i] - mu) * rstd * lw + lb;
            }
        }
    }
}

constexpr int R_QS = 0, R_KS = 17408, R_KT = 34816, R_VT = 55296, R_AS = 75776, R_ST = 84992, R_OB = 119808;
constexpr int LDQ = 136, LDT = 80, LDA = 72, LDO = 132;

__device__ __forceinline__ void ret_write_st(bf16_t* St, const f32x16 (&Sacc)[2], int kt0, int ct, int l31, int hh) {
#pragma unroll
    for (int t2 = 0; t2 < 2; ++t2)
#pragma unroll
        for (int g4 = 0; g4 < 4; ++g4) {
            const int dk0 = (kt0 + t2) * 32 + 8 * g4 + 4 * hh, dv = ct * 32 + l31;
            u32x2 w; w.x = cvt_pk(Sacc[t2][4 * g4 + 0], Sacc[t2][4 * g4 + 1]); w.y = cvt_pk(Sacc[t2][4 * g4 + 2], Sacc[t2][4 * g4 + 3]);
            *(u32x2*)(St + dv * LDQ + dk0) = w;
        }
}

template <bool SAMPLE>
__device__ __forceinline__ void ret_item(const Params& p, unsigned char* lds, int b, int h) {
    bf16_t* Qs = (bf16_t*)(lds + R_QS); bf16_t* Ks = (bf16_t*)(lds + R_KS); bf16_t* Kt = (bf16_t*)(lds + R_KT); bf16_t* Vt = (bf16_t*)(lds + R_VT);
    bf16_t* As = (bf16_t*)(lds + R_AS); bf16_t* St = (bf16_t*)(lds + R_ST); float* Ob = (float*)(lds + R_OB);
    const bf16_t* Z = (const bf16_t*)(p.ws + WS_Z);
    bf16_t* MX = (bf16_t*)(p.ws + WS_MIX);
    const float* tcs = (const float*)(p.ws + WS_COS); const float* tsn = (const float*)(p.ws + WS_SIN);
    const int tid = opaque_tid(), w = tid >> 6, lane = tid & 63, l31 = lane & 31, hh = lane >> 5;
    const float lg = logf(1.0f - exp2f(-5.0f - (float)h));
    const int nchunk = SAMPLE ? 1 : 32;
    const float gL = expf(lg * (SAMPLE ? 8.0f : 64.0f));
    const size_t rowbase = SAMPLE ? (size_t)NPROMPT + (size_t)b * 8 : (size_t)b * 2048;
    const int ct = w & 3, kt0 = (w >> 2) * 2, rt = w >> 2;
    const int si = lane, sd0 = w * 8, sdv0 = w * 16;
    const bool svalid = !SAMPLE || si < 8;
    const float qd = expf(lg * (float)(si + 1)), kd = expf(-lg * (float)(si + 1)) * 0.08838834764831845f;
    const int gi = tid >> 3, gdv0 = (tid & 7) * 16;
    float gwv[16];
#pragma unroll
    for (int e = 0; e < 16; ++e) gwv[e] = p.gn_w[h * 128 + gdv0 + e];
    u32x4 q1, q2, k1, k2, v1, v2, gn1, gn2, gc1, gc2; f32x4 c0, c1, s0, s1;
#define RET_LOAD(cc) do { \
        const size_t _row = rowbase + (size_t)(cc) * 64 + (SAMPLE ? (si & 7) : si); \
        const int _trow = SAMPLE ? 2048 + (si & 7) : (cc) * 64 + si; \
        const bf16_t* _zr = Z + _row * DIN; \
        q1 = *(const u32x4*)(_zr + C_QR + h * 128 + sd0); q2 = *(const u32x4*)(_zr + C_QR + h * 128 + 64 + sd0); \
        k1 = *(const u32x4*)(_zr + C_KR + h * 128 + sd0); k2 = *(const u32x4*)(_zr + C_KR + h * 128 + 64 + sd0); \
        v1 = *(const u32x4*)(_zr + C_VR + h * 128 + sdv0); v2 = *(const u32x4*)(_zr + C_VR + h * 128 + sdv0 + 8); \
        c0 = *(const f32x4*)(tcs + _trow * 64 + sd0); c1 = *(const f32x4*)(tcs + _trow * 64 + sd0 + 4); \
        s0 = *(const f32x4*)(tsn + _trow * 64 + sd0); s1 = *(const f32x4*)(tsn + _trow * 64 + sd0 + 4); \
        const size_t _grow = rowbase + (size_t)(cc) * 64 + (SAMPLE ? (gi & 7) : gi); \
        const bf16_t* _gp = Z + _grow * DIN + C_GR + h * 128 + gdv0; \
        gn1 = *(const u32x4*)_gp; gn2 = *(const u32x4*)(_gp + 8); } while (0)
    RET_LOAD(0);
    f32x16 Sacc[2];
    if (SAMPLE) {
        const float* sp = p.st + (size_t)(b * 4 + h) * 16384;
#pragma unroll
        for (int t2 = 0; t2 < 2; ++t2)
#pragma unroll
            for (int r = 0; r < 16; ++r) { const int dk = (kt0 + t2) * 32 + (r & 3) + 8 * (r >> 2) + 4 * hh; Sacc[t2][r] = sp[dk * 128 + ct * 32 + l31]; }
    } else {
#pragma unroll
        for (int t2 = 0; t2 < 2; ++t2)
#pragma unroll
            for (int r = 0; r < 16; ++r) Sacc[t2][r] = 0.f;
    }
    ret_write_st(St, Sacc, kt0, ct, l31, hh);
    for (int c = 0; c < nchunk; ++c) {
        {
            float qa[8], qb[8], ka[8], kb[8];
#pragma unroll
            for (int e = 0; e < 4; ++e) {
                const unsigned wq1 = q1[e], wq2 = q2[e], wk1 = k1[e], wk2 = k2[e];
#pragma unroll
                for (int hf = 0; hf < 2; ++hf) {
                    const int ee = e * 2 + hf;
                    const float cs = ee < 4 ? c0[ee & 3] : c1[ee & 3], sn = ee < 4 ? s0[ee & 3] : s1[ee & 3];
                    const float x1 = hf ? bf_hi(wq1) : bf_lo(wq1), x2 = hf ? bf_hi(wq2) : bf_lo(wq2);
                    const float y1 = hf ? bf_hi(wk1) : bf_lo(wk1), y2 = hf ? bf_hi(wk2) : bf_lo(wk2);
                    qa[ee] = svalid ? (x1 * cs - x2 * sn) * qd : 0.f; qb[ee] = svalid ? (x2 * cs + x1 * sn) * qd : 0.f;
                    ka[ee] = svalid ? (y1 * cs - y2 * sn) * kd : 0.f; kb[ee] = svalid ? (y2 * cs + y1 * sn) * kd : 0.f;
                }
            }
            const u32x4 pqa = pack8(qa), pqb = pack8(qb), pka = pack8(ka), pkb = pack8(kb);
            *(u32x4*)(Qs + si * LDQ + sd0) = pqa; *(u32x4*)(Qs + si * LDQ + 64 + sd0) = pqb;
            *(u32x4*)(Ks + si * LDQ + sd0) = pka; *(u32x4*)(Ks + si * LDQ + 64 + sd0) = pkb;
#pragma unroll
            for (int e = 0; e < 4; ++e) {
                Kt[(sd0 + 2 * e) * LDT + si] = (bf16_t)(pka[e] & 0xffffu); Kt[(sd0 + 2 * e + 1) * LDT + si] = (bf16_t)(pka[e] >> 16);
                Kt[(64 + sd0 + 2 * e) * LDT + si] = (bf16_t)(pkb[e] & 0xffffu); Kt[(64 + sd0 + 2 * e + 1) * LDT + si] = (bf16_t)(pkb[e] >> 16);
            }
            if (!svalid) { v1 = (u32x4){0u, 0u, 0u, 0u}; v2 = v1; }
#pragma unroll
            for (int e = 0; e < 4; ++e) {
                Vt[(sdv0 + 2 * e) * LDT + si] = (bf16_t)(v1[e] & 0xffffu); Vt[(sdv0 + 2 * e + 1) * LDT + si] = (bf16_t)(v1[e] >> 16);
                Vt[(sdv0 + 8 + 2 * e) * LDT + si] = (bf16_t)(v2[e] & 0xffffu); Vt[(sdv0 + 8 + 2 * e + 1) * LDT + si] = (bf16_t)(v2[e] >> 16);
            }
            gc1 = gn1; gc2 = gn2;
        }
        if (c + 1 < nchunk) RET_LOAD(c + 1);
        lds_barrier();
#pragma unroll
        for (int tq = 0; tq < 2; ++tq) {
            const int tt = w + tq * 8, jt = tt >> 2, it = tt & 3;
            f32x4 a4 = {0.f, 0.f, 0.f, 0.f};
            if (it >= jt) {
#pragma unroll
                for (int kk = 0; kk < 4; ++kk) {
                    const bf16x8 af = *(const bf16x8*)(Ks + (jt * 16 + (lane & 15)) * LDQ + kk * 32 + (lane >> 4) * 8);
                    const bf16x8 bfr = *(const bf16x8*)(Qs + (it * 16 + (lane & 15)) * LDQ + kk * 32 + (lane >> 4) * 8);
                    a4 = mfma16(af, bfr, a4);
                }
            }
            const int i = it * 16 + (lane & 15), j0 = jt * 16 + 4 * (lane >> 4);
            u32x2 wv; wv.x = cvt_pk(i >= j0 ? a4[0] : 0.f, i >= j0 + 1 ? a4[1] : 0.f); wv.y = cvt_pk(i >= j0 + 2 ? a4[2] : 0.f, i >= j0 + 3 ? a4[3] : 0.f);
            *(u32x2*)(As + i * LDA + j0) = wv;
        }
        lds_barrier();
        {
            f32x16 O;
#pragma unroll
            for (int r = 0; r < 16; ++r) O[r] = 0.f;
            bf16x8 vf[4];
#pragma unroll
            for (int ks = 0; ks < 4; ++ks) vf[ks] = *(const bf16x8*)(Vt + (ct * 32 + l31) * LDT + ks * 16 + 8 * hh);
#pragma unroll
            for (int ks = 0; ks < 4; ++ks) { const bf16x8 af = *(const bf16x8*)(As + (rt * 32 + l31) * LDA + ks * 16 + 8 * hh); O = mfma32(af, vf[ks], O); }
#pragma unroll
            for (int ks = 0; ks < 8; ++ks) {
                const bf16x8 af = *(const bf16x8*)(Qs + (rt * 32 + l31) * LDQ + ks * 16 + 8 * hh);
                const bf16x8 bfr = *(const bf16x8*)(St + (ct * 32 + l31) * LDQ + ks * 16 + 8 * hh);
                O = mfma32(af, bfr, O);
            }
#pragma unroll
            for (int t2 = 0; t2 < 2; ++t2) {
#pragma unroll
                for (int ks = 0; ks < 4; ++ks) { const bf16x8 af = *(const bf16x8*)(Kt + ((kt0 + t2) * 32 + l31) * LDT + ks * 16 + 8 * hh); Sacc[t2] = mfma32(af, vf[ks], Sacc[t2]); }
#pragma unroll
                for (int r = 0; r < 16; ++r) Sacc[t2][r] *= gL;
            }
#pragma unroll
            for (int r = 0; r < 16; ++r) { const int i = rt * 32 + (r & 3) + 8 * (r >> 2) + 4 * hh; Ob[i * LDO + ct * 32 + l31] = O[r]; }
        }
        lds_barrier();
        if (c + 1 < nchunk) ret_write_st(St, Sacc, kt0, ct, l31, hh);
        {
            float o[16];
#pragma unroll
            for (int e4 = 0; e4 < 4; ++e4) { const f32x4 v = *(const f32x4*)(Ob + gi * LDO + gdv0 + e4 * 4); o[e4 * 4] = v[0]; o[e4 * 4 + 1] = v[1]; o[e4 * 4 + 2] = v[2]; o[e4 * 4 + 3] = v[3]; }
            float s = 0.f;
#pragma unroll
            for (int e = 0; e < 16; ++e) s += o[e];
            s += __shfl_xor(s, 1); s += __shfl_xor(s, 2); s += __shfl_xor(s, 4);
            const float mu = s * (1.0f / 128.0f);
            float q = 0.f;
#pragma unroll
            for (int e = 0; e < 16; ++e) { const float d = o[e] - mu; q += d * d; }
            q += __shfl_xor(q, 1); q += __shfl_xor(q, 2); q += __shfl_xor(q, 4);
            const float rstd = rsqrtf(q * (1.0f / 128.0f) + 1e-5f);
            if (!SAMPLE || gi < 8) {
                const size_t row = rowbase + (size_t)c * 64 + gi;
                float r8[16];
#pragma unroll
                for (int e = 0; e < 8; ++e) {
                    const unsigned wg = e < 4 ? gc1[e & 3] : gc2[e & 3];
                    const float ga = bf_lo(wg), gb = bf_hi(wg);
                    r8[2 * e] = (o[2 * e] - mu) * rstd * gwv[2 * e] * silu_f(ga);
                    r8[2 * e + 1] = (o[2 * e + 1] - mu) * rstd * gwv[2 * e + 1] * silu_f(gb);
                }
                bf16_t* mp = MX + row * DM + 512 + h * 128 + gdv0;
                *(u32x4*)mp = pack8(r8); *(u32x4*)(mp + 8) = pack8(r8 + 8);
            }
        }
    }
#undef RET_LOAD
    float* dst = p.out + (SAMPLE ? O_SS : O_SP) + (size_t)(b * 4 + h) * 16384;
#pragma unroll
    for (int t2 = 0; t2 < 2; ++t2)
#pragma unroll
        for (int r = 0; r < 16; ++r) { const int dk = (kt0 + t2) * 32 + (r & 3) + 8 * (r >> 2) + 4 * hh; dst[dk * 128 + ct * 32 + l31] = Sacc[t2][r]; }
    lds_barrier();
}

constexpr size_t WS_SC = 400 * MiB;
__device__ __forceinline__ void ret_chain(const Params& p, unsigned char* lds, int b, int h) {
    const bf16_t* Z = (const bf16_t*)(p.ws + WS_Z);
    const float* tcs = (const float*)(p.ws + WS_COS); const float* tsn = (const float*)(p.ws + WS_SIN);
    const int tid = opaque_tid(), w = tid >> 6, lane = tid & 63, l31 = lane & 31, hh = lane >> 5;
    const float lg = __logf(1.0f - exp2f(-5.0f - (float)h));
    const float gL = expf(lg * 64.0f);
    const int ct = w & 3, kt0 = (w >> 2) * 2;
    const int si = tid >> 3, sd0 = (tid & 7) * 8, srot = (tid & 7) * 8;
    const int sc = (si + srot) & 63;
    const float kd = __expf(-lg * (float)(si + 1)) * 0.08838834764831845f;
    u32x2* SC = (u32x2*)(p.ws + WS_SC) + (size_t)(b * 4 + h) * 32 * 4096;
    f32x16 Sacc[2];
#pragma unroll
    for (int t2 = 0; t2 < 2; ++t2)
#pragma unroll
        for (int r = 0; r < 16; ++r) Sacc[t2][r] = 0.f;
    u32x4 k1A, k2A, v1A, v2A, k1B, k2B, v1B, v2B; f32x4 c0A, c1A, s0A, s1A, c0B, c1B, s0B, s1B;
#define CH_LOAD(cc, X) do { \
        const size_t _row = (size_t)b * 2048 + (size_t)(cc) * 64 + si; const int _trow = (cc) * 64 + si; \
        const bf16_t* _zr = Z + _row * DIN; \
        k1##X = *(const u32x4*)(_zr + C_KR + h * 128 + sd0); k2##X = *(const u32x4*)(_zr + C_KR + h * 128 + 64 + sd0); \
        v1##X = *(const u32x4*)(_zr + C_VR + h * 128 + sd0); v2##X = *(const u32x4*)(_zr + C_VR + h * 128 + 64 + sd0); \
        c0##X = *(const f32x4*)(tcs + _trow * 64 + sd0); c1##X = *(const f32x4*)(tcs + _trow * 64 + sd0 + 4); \
        s0##X = *(const f32x4*)(tsn + _trow * 64 + sd0); s1##X = *(const f32x4*)(tsn + _trow * 64 + sd0 + 4); } while (0)
#define CH_STORE(bufi, X) do { \
        bf16_t* _Kt = (bf16_t*)(lds + (bufi) * 40960); bf16_t* _Vt = (bf16_t*)(lds + (bufi) * 40960 + 20480); \
        float ka[8], kb[8]; \
        _Pragma("unroll") for (int e = 0; e < 4; ++e) { const unsigned wk1 = k1##X[e], wk2 = k2##X[e]; \
            _Pragma("unroll") for (int hf = 0; hf < 2; ++hf) { const int ee = e * 2 + hf; \
                const float cs = ee < 4 ? c0##X[ee & 3] : c1##X[ee & 3], sn = ee < 4 ? s0##X[ee & 3] : s1##X[ee & 3]; \
                const float y1 = hf ? bf_hi(wk1) : bf_lo(wk1), y2 = hf ? bf_hi(wk2) : bf_lo(wk2); \
                ka[ee] = (y1 * cs - y2 * sn) * kd; kb[ee] = (y2 * cs + y1 * sn) * kd; } } \
        const u32x4 pka = pack8(ka), pkb = pack8(kb); \
        _Pragma("unroll") for (int e = 0; e < 4; ++e) { \
            _Kt[(sd0 + 2 * e) * LDT + sc] = (bf16_t)(pka[e] & 0xffffu); _Kt[(sd0 + 2 * e + 1) * LDT + sc] = (bf16_t)(pka[e] >> 16); \
            _Kt[(64 + sd0 + 2 * e) * LDT + sc] = (bf16_t)(pkb[e] & 0xffffu); _Kt[(64 + sd0 + 2 * e + 1) * LDT + sc] = (bf16_t)(pkb[e] >> 16); \
            _Vt[(sd0 + 2 * e) * LDT + sc] = (bf16_t)(v1##X[e] & 0xffffu); _Vt[(sd0 + 2 * e + 1) * LDT + sc] = (bf16_t)(v1##X[e] >> 16); \
            _Vt[(64 + sd0 + 2 * e) * LDT + sc] = (bf16_t)(v2##X[e] & 0xffffu); _Vt[(64 + sd0 + 2 * e + 1) * LDT + sc] = (bf16_t)(v2##X[e] >> 16); } } while (0)
#define CH_STEP(c, X) do { \
        lds_barrier(); \
        { u32x2* dst = SC + (size_t)(((c) + 31) & 31) * 4096 + (size_t)w * 512 + lane; \
          _Pragma("unroll") for (int t2 = 0; t2 < 2; ++t2) _Pragma("unroll") for (int g4 = 0; g4 < 4; ++g4) { \
              u32x2 wv; wv.x = cvt_pk(Sacc[t2][4 * g4 + 0], Sacc[t2][4 * g4 + 1]); wv.y = cvt_pk(Sacc[t2][4 * g4 + 2], Sacc[t2][4 * g4 + 3]); \
              dst[(t2 * 4 + g4) * 64] = wv; } } \
        CH_STORE(((c) + 1) & 1, X); \
        { const int cn = (c) + 3 < 32 ? (c) + 3 : 31; CH_LOAD(cn, X); } \
        asm volatile("" ::: "memory"); __builtin_amdgcn_sched_barrier(0); \
        { const bf16_t* Kt = (const bf16_t*)(lds + ((c) & 1) * 40960); const bf16_t* Vt = (const bf16_t*)(lds + ((c) & 1) * 40960 + 20480); \
          bf16x8 vf[4]; \
          _Pragma("unroll") for (int ks = 0; ks < 4; ++ks) vf[ks] = *(const bf16x8*)(Vt + (ct * 32 + l31) * LDT + ((ks * 16 + 8 * hh + 8 * (((ct * 32 + l31) >> 3) & 7)) & 63)); \
          _Pragma("unroll") for (int t2 = 0; t2 < 2; ++t2) { \
              _Pragma("unroll") for (int ks = 0; ks < 4; ++ks) { const bf16x8 af = *(const bf16x8*)(Kt + ((kt0 + t2) * 32 + l31) * LDT + ((ks * 16 + 8 * hh + 8 * ((((kt0 + t2) * 32 + l31) >> 3) & 7)) & 63)); Sacc[t2] = mfma32(af, vf[ks], Sacc[t2]); } \
              _Pragma("unroll") for (int r = 0; r < 16; ++r) Sacc[t2][r] *= gL; } } } while (0)
    CH_LOAD(0, A);
    CH_STORE(0, A);
    CH_LOAD(1, A);
    CH_LOAD(2, B);
    for (int c = 0; c < 32; c += 2) {
        CH_STEP(c, A);
        CH_STEP(c + 1, B);
    }
#undef CH_LOAD
#undef CH_STORE
#undef CH_STEP
    float* dst = p.out + O_SP + (size_t)(b * 4 + h) * 16384;
#pragma unroll
    for (int t2 = 0; t2 < 2; ++t2)
#pragma unroll
        for (int r = 0; r < 16; ++r) { const int dk = (kt0 + t2) * 32 + (r & 3) + 8 * (r >> 2) + 4 * hh; dst[dk * 128 + ct * 32 + l31] = Sacc[t2][r]; }
    lds_barrier();
}

__device__ __forceinline__ void ret_out_item(const Params& p, unsigned char* lds, int b, int h, int c) {
    bf16_t* Qs = (bf16_t*)(lds + R_QS); bf16_t* Ks = (bf16_t*)(lds + R_KS); bf16_t* Vt = (bf16_t*)(lds + R_VT);
    bf16_t* As = (bf16_t*)(lds + R_AS); bf16_t* St = (bf16_t*)(lds + R_ST); float* Ob = (float*)(lds + R_OB);
    const bf16_t* Z = (const bf16_t*)(p.ws + WS_Z);
    bf16_t* MX = (bf16_t*)(p.ws + WS_MIX);
    const float* tcs = (const float*)(p.ws + WS_COS); const float* tsn = (const float*)(p.ws + WS_SIN);
    const int tid = opaque_tid(), w = tid >> 6, lane = tid & 63, l31 = lane & 31, hh = lane >> 5;
    const float lg = __logf(1.0f - exp2f(-5.0f - (float)h));
    const int ct = w & 3, kt0 = (w >> 2) * 2, rt = w >> 2;
    const int si = tid >> 3, sd0 = (tid & 7) * 8, sc = (si + (tid & 7) * 8) & 63;
    const float qd = __expf(lg * (float)(si + 1)), kd = __expf(-lg * (float)(si + 1)) * 0.08838834764831845f;
    const int gi = tid >> 3, gdv0 = (tid & 7) * 16;
    const size_t row = (size_t)b * 2048 + (size_t)c * 64 + si; const int trow = c * 64 + si;
    const bf16_t* zr = Z + row * DIN;
    const u32x4 q1 = *(const u32x4*)(zr + C_QR + h * 128 + sd0), q2 = *(const u32x4*)(zr + C_QR + h * 128 + 64 + sd0);
    const u32x4 k1 = *(const u32x4*)(zr + C_KR + h * 128 + sd0), k2 = *(const u32x4*)(zr + C_KR + h * 128 + 64 + sd0);
    const u32x4 v1 = *(const u32x4*)(zr + C_VR + h * 128 + sd0), v2 = *(const u32x4*)(zr + C_VR + h * 128 + 64 + sd0);
    const f32x4 c0 = *(const f32x4*)(tcs + trow * 64 + sd0), c1 = *(const f32x4*)(tcs + trow * 64 + sd0 + 4);
    const f32x4 s0 = *(const f32x4*)(tsn + trow * 64 + sd0), s1 = *(const f32x4*)(tsn + trow * 64 + sd0 + 4);
    const size_t grow = (size_t)b * 2048 + (size_t)c * 64 + gi;
    const bf16_t* gp = Z + grow * DIN + C_GR + h * 128 + gdv0;
    const u32x4 gc1 = *(const u32x4*)gp, gc2 = *(const u32x4*)(gp + 8);
    u32x2 sfr[8];
    if (c > 0) {
        const u32x2* src = (const u32x2*)(p.ws + WS_SC) + ((size_t)(b * 4 + h) * 32 + (c - 1)) * 4096 + (size_t)w * 512 + lane;
#pragma unroll
        for (int f = 0; f < 8; ++f) sfr[f] = src[f * 64];
    } else {
#pragma unroll
        for (int f = 0; f < 8; ++f) sfr[f] = (u32x2){0u, 0u};
    }
    float gwv[16];
#pragma unroll
    for (int e4 = 0; e4 < 4; ++e4) { const f32x4 t4 = *(const f32x4*)(p.gn_w + h * 128 + gdv0 + e4 * 4); gwv[e4 * 4] = t4[0]; gwv[e4 * 4 + 1] = t4[1]; gwv[e4 * 4 + 2] = t4[2]; gwv[e4 * 4 + 3] = t4[3]; }
    {
        float qa[8], qb[8], ka[8], kb[8];
#pragma unroll
        for (int e = 0; e < 4; ++e) {
            const unsigned wq1 = q1[e], wq2 = q2[e], wk1 = k1[e], wk2 = k2[e];
#pragma unroll
            for (int hf = 0; hf < 2; ++hf) {
                const int ee = e * 2 + hf;
                const float cs = ee < 4 ? c0[ee & 3] : c1[ee & 3], sn = ee < 4 ? s0[ee & 3] : s1[ee & 3];
                const float x1 = hf ? bf_hi(wq1) : bf_lo(wq1), x2 = hf ? bf_hi(wq2) : bf_lo(wq2);
                const float y1 = hf ? bf_hi(wk1) : bf_lo(wk1), y2 = hf ? bf_hi(wk2) : bf_lo(wk2);
                qa[ee] = (x1 * cs - x2 * sn) * qd; qb[ee] = (x2 * cs + x1 * sn) * qd;
                ka[ee] = (y1 * cs - y2 * sn) * kd; kb[ee] = (y2 * cs + y1 * sn) * kd;
            }
        }
        *(u32x4*)(Qs + si * LDQ + sd0) = pack8(qa); *(u32x4*)(Qs + si * LDQ + 64 + sd0) = pack8(qb);
        *(u32x4*)(Ks + si * LDQ + sd0) = pack8(ka); *(u32x4*)(Ks + si * LDQ + 64 + sd0) = pack8(kb);
#pragma unroll
        for (int e = 0; e < 4; ++e) {
            Vt[(sd0 + 2 * e) * LDT + sc] = (bf16_t)(v1[e] & 0xffffu); Vt[(sd0 + 2 * e + 1) * LDT + sc] = (bf16_t)(v1[e] >> 16);
            Vt[(64 + sd0 + 2 * e) * LDT + sc] = (bf16_t)(v2[e] & 0xffffu); Vt[(64 + sd0 + 2 * e + 1) * LDT + sc] = (bf16_t)(v2[e] >> 16);
        }
#pragma unroll
        for (int t2 = 0; t2 < 2; ++t2)
#pragma unroll
            for (int g4 = 0; g4 < 4; ++g4) { const int dk0 = (kt0 + t2) * 32 + 8 * g4 + 4 * hh, dv = ct * 32 + l31; *(u32x2*)(St + dv * LDQ + dk0) = sfr[t2 * 4 + g4]; }
    }
    lds_barrier();
#pragma unroll
    for (int tq = 0; tq < 2; ++tq) {
        const int tt = w + tq * 8, jt = tt >> 2, it = tt & 3;
        f32x4 a4 = {0.f, 0.f, 0.f, 0.f};
        if (it >= jt) {
#pragma unroll
            for (int kk = 0; kk < 4; ++kk) {
                const bf16x8 af = *(const bf16x8*)(Ks + (jt * 16 + (lane & 15)) * LDQ + kk * 32 + (lane >> 4) * 8);
                const bf16x8 bfr = *(const bf16x8*)(Qs + (it * 16 + (lane & 15)) * LDQ + kk * 32 + (lane >> 4) * 8);
                a4 = mfma16(af, bfr, a4);
            }
        }
        const int i = it * 16 + (lane & 15), j0 = jt * 16 + 4 * (lane >> 4);
        u32x2 wv; wv.x = cvt_pk(i >= j0 ? a4[0] : 0.f, i >= j0 + 1 ? a4[1] : 0.f); wv.y = cvt_pk(i >= j0 + 2 ? a4[2] : 0.f, i >= j0 + 3 ? a4[3] : 0.f);
        *(u32x2*)(As + i * LDA + j0) = wv;
    }
    lds_barrier();
    {
        f32x16 O;
#pragma unroll
        for (int r = 0; r < 16; ++r) O[r] = 0.f;
#pragma unroll
        for (int ks = 0; ks < 4; ++ks) {
            const bf16x8 vfr = *(const bf16x8*)(Vt + (ct * 32 + l31) * LDT + ((ks * 16 + 8 * hh + 8 * (((ct * 32 + l31) >> 3) & 7)) & 63));
            const bf16x8 af = *(const bf16x8*)(As + (rt * 32 + l31) * LDA + ks * 16 + 8 * hh);
            O = mfma32(af, vfr, O);
        }
#pragma unroll
        for (int ks = 0; ks < 8; ++ks) {
            const bf16x8 af = *(const bf16x8*)(Qs + (rt * 32 + l31) * LDQ + ks * 16 + 8 * hh);
            const bf16x8 bfr = *(const bf16x8*)(St + (ct * 32 + l31) * LDQ + ks * 16 + 8 * hh);
            O = mfma32(af, bfr, O);
        }
#pragma unroll
        for (int r = 0; r < 16; ++r) { const int i = rt * 32 + (r & 3) + 8 * (r >> 2) + 4 * hh; Ob[i * LDO + ct * 32 + l31] = O[r]; }
    }
    lds_barrier();
    {
        float o[16];
#pragma unroll
        for (int e4 = 0; e4 < 4; ++e4) { const f32x4 v = *(const f32x4*)(Ob + gi * LDO + gdv0 + e4 * 4); o[e4 * 4] = v[0]; o[e4 * 4 + 1] = v[1]; o[e4 * 4 + 2] = v[2]; o[e4 * 4 + 3] = v[3]; }
        float sm = 0.f;
#pragma unroll
        for (int e = 0; e < 16; ++e) sm += o[e];
        sm += __shfl_xor(sm, 1); sm += __shfl_xor(sm, 2); sm += __shfl_xor(sm, 4);
        const float mu = sm * (1.0f / 128.0f);
        float q = 0.f;
#pragma unroll
        for (int e = 0; e < 16; ++e) { const float d = o[e] - mu; q += d * d; }
        q += __shfl_xor(q, 1); q += __shfl_xor(q, 2); q += __shfl_xor(q, 4);
        const float rstd = rsqrtf(q * (1.0f / 128.0f) + 1e-5f);
        float r8[16];
#pragma unroll
        for (int e = 0; e < 8; ++e) {
            const unsigned wg = e < 4 ? gc1[e & 3] : gc2[e & 3];
            r8[2 * e] = (o[2 * e] - mu) * rstd * gwv[2 * e] * silu_f(bf_lo(wg));
            r8[2 * e + 1] = (o[2 * e + 1] - mu) * rstd * gwv[2 * e + 1] * silu_f(bf_hi(wg));
        }
        bf16_t* mp = MX + grow * DM + 512 + h * 128 + gdv0;
        *(u32x4*)mp = pack8(r8); *(u32x4*)(mp + 8) = pack8(r8 + 8);
    }
    lds_barrier();
}

constexpr int W_KS = 0, W_VT = 36864;
constexpr int LDK = 72, LDV = 264;

template <bool SAMPLE>
__device__ __forceinline__ void swa_item(const Params& p, unsigned char* lds, int b, int blk, int kvh) {
    bf16_t* Ksw = (bf16_t*)(lds + W_KS); bf16_t* Vtw = (bf16_t*)(lds + W_VT);
    const bf16_t* Z = (const bf16_t*)(p.ws + WS_Z);
    bf16_t* MX = (bf16_t*)(p.ws + WS_MIX);
    const int tid = opaque_tid(), w = tid >> 6, lane = tid & 63, l31 = lane & 31, hh = lane >> 5;
    constexpr int NKEYS = SAMPLE ? 160 : 256;
    constexpr int NT = SAMPLE ? 1 : 2;
    bf16x8 Qf[4];
#define SWA_LOADQ(q2v) do { \
        const int _i0 = SAMPLE ? 0 : ((w & 1) * 2 + (q2v)) * 32; \
        const size_t _qrow = SAMPLE ? (size_t)NPROMPT + (size_t)b * 8 + (l31 & 7) : (size_t)b * 2048 + blk * 128 + _i0 + l31; \
        const int _head = SAMPLE ? kvh * 4 + (l31 >> 3) : kvh * 4 + (w >> 1); \
        _Pragma("unroll") for (int ks = 0; ks < 4; ++ks) Qf[ks] = *(const bf16x8*)(Z + _qrow * DIN + C_QA + _head * 64 + ks * 16 + 8 * hh); } while (0)
    SWA_LOADQ(0);
    for (int idx = tid; idx < NKEYS * 8; idx += 512) {
        const int j = idx >> 3, d0 = (idx & 7) * 8;
        u32x4 kq = {0u, 0u, 0u, 0u}, vq = {0u, 0u, 0u, 0u};
        if (!SAMPLE) {
            const int tk = blk * 128 - 128 + j;
            if (tk >= 0) { const bf16_t* zr = Z + ((size_t)b * 2048 + tk) * DIN; kq = *(const u32x4*)(zr + C_KA + kvh * 64 + d0); vq = *(const u32x4*)(zr + C_VA + kvh * 64 + d0); }
        } else {
            if (j < 128) {
                const float* ckp = p.ck + (((size_t)b * 128 + j) * 2 + kvh) * 64 + d0; const float* cvp = p.cv + (((size_t)b * 128 + j) * 2 + kvh) * 64 + d0;
                const f32x4 a0 = *(const f32x4*)ckp, a1 = *(const f32x4*)(ckp + 4), b0 = *(const f32x4*)cvp, b1 = *(const f32x4*)(cvp + 4);
                kq.x = cvt_pk(a0[0], a0[1]); kq.y = cvt_pk(a0[2], a0[3]); kq.z = cvt_pk(a1[0], a1[1]); kq.w = cvt_pk(a1[2], a1[3]);
                vq.x = cvt_pk(b0[0], b0[1]); vq.y = cvt_pk(b0[2], b0[3]); vq.z = cvt_pk(b1[0], b1[1]); vq.w = cvt_pk(b1[2], b1[3]);
            } else if (j < 136) {
                const bf16_t* zr = Z + ((size_t)NPROMPT + (size_t)b * 8 + (j - 128)) * DIN; kq = *(const u32x4*)(zr + C_KA + kvh * 64 + d0); vq = *(const u32x4*)(zr + C_VA + kvh * 64 + d0);
            }
        }
        *(u32x4*)(Ksw + j * LDK + d0) = kq;
        const int kk = j & 15, jp = (((j & ~15) | (((kk >> 2) & 1) << 3) | (((kk >> 3) & 1) << 2) | (kk & 3)) + d0) & 255;
#pragma unroll
        for (int e = 0; e < 4; ++e) { Vtw[(d0 + 2 * e) * LDV + jp] = (bf16_t)(vq[e] & 0xffffu); Vtw[(d0 + 2 * e + 1) * LDV + jp] = (bf16_t)(vq[e] >> 16); }
    }
    lds_barrier();
    if (!SAMPLE || w == 0) {
        const int g = w >> 1;
#pragma unroll 1
        for (int q2 = 0; q2 < NT; ++q2) {

            const int i0 = SAMPLE ? 0 : ((w & 1) * 2 + q2) * 32;
                        const int head = SAMPLE ? kvh * 4 + (l31 >> 3) : kvh * 4 + g;
            const int iq = SAMPLE ? (l31 & 7) : i0 + l31;
            const float sink = p.sinks[head];
            f32x16 S[5];
#pragma unroll
            for (int kt = 0; kt < 5; ++kt) {
#pragma unroll
                for (int r = 0; r < 16; ++r) S[kt][r] = 0.f;
#pragma unroll
                for (int ks = 0; ks < 4; ++ks) { const bf16x8 kf = *(const bf16x8*)(Ksw + (i0 + 32 * kt + l31) * LDK + ks * 16 + 8 * hh); S[kt] = mfma32(kf, Qf[ks], S[kt]); }
            }
            if (q2 + 1 < NT) SWA_LOADQ(q2 + 1);
            float m = sink;
#pragma unroll
            for (int kt = 0; kt < 5; ++kt)
#pragma unroll
                for (int r = 0; r < 16; ++r) {
                    const int j = i0 + 32 * kt + (r & 3) + 8 * (r >> 2) + 4 * hh;
                    const bool valid = (j >= iq) && (j <= iq + 128) && (SAMPLE || blk > 0 || j >= 128);
                    const float s = valid ? S[kt][r] * 0.125f : -1e30f;
                    S[kt][r] = s; m = fmaxf(m, s);
                }
            m = fmaxf(m, __shfl_xor(m, 32));
            float sum = 0.f;
#pragma unroll
            for (int kt = 0; kt < 5; ++kt)
#pragma unroll
                for (int r = 0; r < 16; ++r) { const float e = __expf(S[kt][r] - m); S[kt][r] = e; sum += e; }
            sum += __shfl_xor(sum, 32);
            const float inv = 1.0f / (sum + __expf(sink - m));
            bf16_t graw[2][16];
#pragma unroll
            for (int dt = 0; dt < 2; ++dt)
#pragma unroll
                for (int r = 0; r < 16; ++r) {
                    const int qc = (r & 3) + 8 * (r >> 2) + 4 * hh;
                    const size_t orow = SAMPLE ? (size_t)NPROMPT + (size_t)b * 8 + (qc & 7) : (size_t)b * 2048 + blk * 128 + i0 + qc;
                    const int col = (SAMPLE ? kvh * 4 + (qc >> 3) : kvh * 4 + g) * 64 + dt * 32 + l31;
                    graw[dt][r] = Z[orow * DIN + C_GA + col];
                }
            f32x16 O[2];
#pragma unroll
            for (int dt = 0; dt < 2; ++dt)
#pragma unroll
                for (int r = 0; r < 16; ++r) O[dt][r] = 0.f;
#pragma unroll
            for (int kt = 0; kt < 5; ++kt)
#pragma unroll
                for (int s2 = 0; s2 < 2; ++s2) {
                    u32x4 pw;
                    pw.x = cvt_pk(S[kt][8 * s2 + 0] * inv, S[kt][8 * s2 + 1] * inv); pw.y = cvt_pk(S[kt][8 * s2 + 2] * inv, S[kt][8 * s2 + 3] * inv);
                    pw.z = cvt_pk(S[kt][8 * s2 + 4] * inv, S[kt][8 * s2 + 5] * inv); pw.w = cvt_pk(S[kt][8 * s2 + 6] * inv, S[kt][8 * s2 + 7] * inv);
#pragma unroll
                    for (int dt = 0; dt < 2; ++dt) { const bf16x8 vfr = *(const bf16x8*)(Vtw + (dt * 32 + l31) * LDV + ((i0 + 32 * kt + 16 * s2 + 8 * hh + 8 * (((dt * 32 + l31) >> 3) & 7)) & 255)); O[dt] = mfma32(as_frag(pw), vfr, O[dt]); }
                }
#pragma unroll
            for (int dt = 0; dt < 2; ++dt)
#pragma unroll
                for (int r = 0; r < 16; ++r) {
                    const int qc = (r & 3) + 8 * (r >> 2) + 4 * hh;
                    const size_t orow = SAMPLE ? (size_t)NPROMPT + (size_t)b * 8 + (qc & 7) : (size_t)b * 2048 + blk * 128 + i0 + qc;
                    const int col = (SAMPLE ? kvh * 4 + (qc >> 3) : kvh * 4 + g) * 64 + dt * 32 + l31;
                    const float gv = __uint_as_float(((unsigned)graw[dt][r]) << 16);
                    MX[orow * DM + col] = (bf16_t)(cvt_pk(O[dt][r] * silu_f(gv), 0.f) & 0xffffu);
                }
        }
    }
    lds_barrier();
#undef SWA_LOADQ
}

__device__ __forceinline__ void p2a_mixers(const Params& p, unsigned char* lds) {
    const int G = gridDim.x, bx = blockIdx.x;
    const int NRET = 64;
    if (G > NRET) {
        if (bx < NRET) { ret_chain(p, lds, bx >> 2, bx & 3); return; }
    } else {
        for (int it = bx; it < NRET; it += G) ret_chain(p, lds, it >> 2, it & 3);
    }
    const int nb = G > NRET ? G - NRET : G, me = G > NRET ? bx - NRET : bx;
    for (int it = me; it < 512 + 512 + 256; it += nb) {
        if (it < 512) { swa_item<false>(p, lds, it >> 5, (it >> 1) & 15, it & 1); }
        else if (it < 1024) { const int s = it - 512; ret_item<true>(p, lds, s >> 2, s & 3); }
        else { const int s = it - 1024; swa_item<true>(p, lds, s >> 1, 0, s & 1); }
    }
}
__device__ __forceinline__ void p2b_ret_out(const Params& p, unsigned char* lds) {
    for (int it = blockIdx.x; it < 2048; it += gridDim.x) ret_out_item(p, lds, it >> 7, (it >> 5) & 3, it & 31);
}

__global__ void __launch_bounds__(512) hymba_fwd(Params p) {
    extern __shared__ __attribute__((aligned(16))) unsigned char lds[];
    cg::grid_group grid = cg::this_grid();
    unsigned* bar = (unsigned*)(p.ws + WS_BAR);
    if (blockIdx.x == 0 && threadIdx.x == 0) __hip_atomic_store(bar, 0u, __ATOMIC_RELAXED, __HIP_MEMORY_SCOPE_AGENT);
    p0_prologue(p, lds);
    grid.sync();
    p1a_modulate(p);
    fast_grid_barrier(bar, 1u);
    {
        pg8::Gemm g{(const pg8::bf16_t*)(p.ws + WS_H), (const pg8::bf16_t*)(p.ws + WS_WIN), MROWS, DIN, DM};
        pg8::StaticOrder S; S.init(MROWS, DIN, (int)gridDim.x, (int)blockIdx.x);
        EpiZ E{(bf16_t*)(p.ws + WS_Z), p.out};
        pg8::gemm_phase<EpiZ, pg8::StaticOrder>((PG8_LAS unsigned char*)lds, g, S, E);
    }
    fast_grid_barrier(bar, 2u);
    p2a_mixers(p, lds);
    fast_grid_barrier(bar, 3u);
    p2b_ret_out(p, lds);
    fast_grid_barrier(bar, 4u);
    {
        pg8::Gemm g{(const pg8::bf16_t*)(p.ws + WS_MIX), (const pg8::bf16_t*)(p.ws + WS_WOUT), MROWS, DM, DM};
        pg8::StaticOrder S; S.init(MROWS, DM, (int)gridDim.x, (int)blockIdx.x);
        EpiY E{(bf16_t*)(p.ws + WS_Y)};
        pg8::gemm_phase<EpiY, pg8::StaticOrder>((PG8_LAS unsigned char*)lds, g, S, E);
    }
    fast_grid_barrier(bar, 5u);
    p4_layernorm(p);
}

extern "C" void kernel_launch(void* const* d_in, const int* in_sizes, int n_in, void* d_out, int out_size, void* d_ws, size_t ws_size, hipStream_t stream) {
    static int grid_blocks = 0;
    if (!grid_blocks) {
        int dev = 0, cus = 0, per_cu = 0;
        hipGetDevice(&dev);
        hipDeviceGetAttribute(&cus, hipDeviceAttributeMultiprocessorCount, dev);
        hipFuncSetAttribute((const void*)hymba_fwd, hipFuncAttributeMaxDynamicSharedMemorySize, LDS_BYTES);
        hipOccupancyMaxActiveBlocksPerMultiprocessor(&per_cu, (const void*)hymba_fwd, 512, LDS_BYTES);
        if (per_cu < 1) { fprintf(stderr, "kernel_launch: occupancy query reports %d blocks per CU\n", per_cu); per_cu = 1; }
        grid_blocks = cus * per_cu;
        if (grid_blocks > 256) grid_blocks = 256;
    }
    Params p{};
    p.xp = (const float*)d_in[0]; p.xs = (const float*)d_in[1]; p.cp = (const float*)d_in[2]; p.cs = (const float*)d_in[3];
    p.ck = (const float*)d_in[4]; p.cv = (const float*)d_in[5]; p.st = (const float*)d_in[6];
    p.w_ada = (const float*)d_in[7]; p.b_ada = (const float*)d_in[8]; p.w_in = (const float*)d_in[9]; p.sinks = (const float*)d_in[10];
    p.gn_w = (const float*)d_in[11]; p.w_out = (const float*)d_in[12]; p.ln_w = (const float*)d_in[13]; p.ln_b = (const float*)d_in[14];
    p.out = (float*)d_out; p.ws = (unsigned char*)d_ws;
    void* args[] = {&p};
    hipError_t e = hipLaunchCooperativeKernel((const void*)hymba_fwd, dim3(grid_blocks), dim3(512), args, LDS_BYTES, stream);
    if (e != hipSuccess) fprintf(stderr, "cooperative launch failed: %s (grid %d)\n", hipGetErrorString(e), grid_blocks);
}
```

```cpp
#include <hip/hip_runtime.h>
#include <hip/hip_cooperative_groups.h>
#include <cstdio>
namespace cg = cooperative_groups;
__device__ __forceinline__ void lds_barrier() { asm volatile("s_waitcnt lgkmcnt(0)" ::: "memory"); __builtin_amdgcn_s_barrier(); asm volatile("" ::: "memory"); }
__device__ __forceinline__ void fast_grid_barrier(unsigned* bar, unsigned seam) {
    __syncthreads();
    if (threadIdx.x == 0) {
        __builtin_amdgcn_fence(__ATOMIC_RELEASE, "agent");
        __hip_atomic_fetch_add(bar, 1u, __ATOMIC_RELAXED, __HIP_MEMORY_SCOPE_AGENT);
        const unsigned target = seam * gridDim.x;
        while (__hip_atomic_load(bar, __ATOMIC_RELAXED, __HIP_MEMORY_SCOPE_AGENT) < target) __builtin_amdgcn_s_sleep(2);
        __builtin_amdgcn_fence(__ATOMIC_ACQUIRE, "agent");
    }
    __syncthreads();
}
__device__ __forceinline__ int opaque_tid() { int t = threadIdx.x; asm volatile("" : "+v"(t)); return t; }
namespace pg8 {
#define PG8_LAS __attribute__((address_space(3)))
typedef unsigned short bf16_t;
typedef short bf16x8 __attribute__((ext_vector_type(8)));
typedef float f32x4 __attribute__((ext_vector_type(4)));
typedef unsigned u32x4 __attribute__((ext_vector_type(4)));
constexpr int BM = 256, BK = 64, HALF = 128, HTB = HALF * BK * 2  , STAGE_BYTES = 8 * HTB, NXCD = 8, WGM = 8;

__host__ __device__ __forceinline__ int lds_byte(int r, int c) { const int st = (r >> 4) * 2 + (c >> 5), rr = r & 15, cc = c & 31, ob = rr * 64 + cc * 2; return st * 1024 + (ob ^ (((ob >> 9) & 1) << 5)); }
__host__ __device__ __forceinline__ void stage_rc(int b, int& R, int& C) { const int st = b / 1024, sb = b % 1024, swz = sb ^ (((sb >> 9) & 1) << 5); R = (st >> 1) * 16 + swz / 64; C = (st & 1) * 32 + (swz % 64) / 2; }
__host__ __device__ __forceinline__ int perm32(int rho) { const int n = rho >> 4, i = rho & 15; return 8 * (i >> 2) + 4 * n + (i & 3); }

struct Unit { int pm, pn; };
struct Gemm { const bf16_t* A; const bf16_t* Bt; int M, N, K; };

struct StaticOrder {
    int nM, nN, nwg, G, c;
    __host__ __device__ void init(int M, int N, int G_, int c_) { nM = M / BM; nN = N / BM; nwg = nM * nN; G = G_; c = c_; }
    __host__ __device__ bool next(int i, Unit& u) const {
        const long L = (long)i * G + c; if (L >= nwg) return false;
        int wgid = (int)L; { const int q = nwg / NXCD, r = nwg % NXCD, xcd = wgid % NXCD, off = wgid / NXCD; wgid = (xcd < r ? xcd * (q + 1) : r * (q + 1) + (xcd - r) * q) + off; }
        const int nig = WGM * nN, gid = wgid / nig, fm = gid * WGM, gsz = (nM - fm) < WGM ? (nM - fm) : WGM;
        u.pm = fm + ((wgid % nig) % gsz); u.pn = (wgid % nig) / gsz; return true;
    }
    __device__ __forceinline__ void a_ready(const Unit&) const {}
    __device__ __forceinline__ void done(const Unit&) const {}
};
__device__ __forceinline__ unsigned cvt_pk_bf16(float lo, float hi) { unsigned r; asm volatile("v_cvt_pk_bf16_f32 %0, %1, %2" : "=v"(r) : "v"(lo), "v"(hi)); return r; }
template <class Epi, class Sched>
__device__ __forceinline__ void gemm_phase(PG8_LAS unsigned char* lds, const Gemm g, const Sched& S, const Epi& E) {
    const int tid = opaque_tid(), wid = __builtin_amdgcn_readfirstlane(tid >> 6), lane = tid & 63, wr = wid >> 2, wc = wid & 3, fr = lane & 15, fq = lane >> 4;
    const int K = g.K, nt = K / BK;
    unsigned voffA[2], voffB[2];
#pragma unroll
    for (int i = 0; i < 2; ++i) { int R, C; stage_rc(tid * 16 + i * 8192, R, C); const int Rb = Epi::PERM ? ((R & ~31) + perm32(R & 31)) : R;
        voffA[i] = (unsigned)(R * K + C) * 2u; voffB[i] = (unsigned)(Rb * K + C) * 2u; }
    const size_t kstep = (size_t)(BK * 2);
    const size_t hstep = (size_t)HALF * K * 2;
    const size_t tstep = 2 * hstep;
    const unsigned ldsw = (unsigned)wid * 1024u;
    const int aoff = lds_byte(wr * 64 + fr, fq * 8), boff = lds_byte(wc * 32 + fr, fq * 8);
#define PG8_SA(b, h) (((b) * 2 + (h)) * HTB)
#define PG8_SB(b, h) ((4 + (b) * 2 + (h)) * HTB)
#define PG8_STAGE(bufoff, gbase, voff) do { _Pragma("unroll") for (int _i = 0; _i < 2; ++_i) \
        __builtin_amdgcn_global_load_lds((const unsigned*)((const char*)(gbase) + (voff)[_i]), (PG8_LAS unsigned*)(lds + (bufoff) + ldsw + _i * 8192), 16, 0, 0); } while (0)
#define PG8_LDA(dst, b, h) do { _Pragma("unroll") for (int m = 0; m < 4; ++m) _Pragma("unroll") for (int k = 0; k < 2; ++k) dst[m][k] = *(const PG8_LAS bf16x8*)(lds + PG8_SA(b, h) + aoff + m * 2048 + k * 1024); } while (0)
#define PG8_LDB(dst, b, h) do { _Pragma("unroll") for (int n = 0; n < 2; ++n) _Pragma("unroll") for (int k = 0; k < 2; ++k) dst[n][k] = *(const PG8_LAS bf16x8*)(lds + PG8_SB(b, h) + boff + n * 2048 + k * 1024); } while (0)
#define PG8_MMA(ai, bj, At, Bt) do { __builtin_amdgcn_s_setprio(1); _Pragma("unroll") for (int m = 0; m < 4; ++m) _Pragma("unroll") for (int n = 0; n < 2; ++n) _Pragma("unroll") for (int k = 0; k < 2; ++k) \
        acc[ai][bj][m][n] = __builtin_amdgcn_mfma_f32_16x16x32_bf16(Bt[n][k], At[m][k], acc[ai][bj][m][n], 0, 0, 0); __builtin_amdgcn_s_setprio(0); } while (0)
#define PG8_WAIT_V(n) asm volatile("s_waitcnt vmcnt(" #n ")" ::: "memory")
#define PG8_WAIT_L(n) asm volatile("s_waitcnt lgkmcnt(" #n ")" ::: "memory")
#define PG8_BAR __builtin_amdgcn_s_barrier()
#define PG8_SCHED __builtin_amdgcn_sched_barrier(0)
    Unit cur, nxt; int ui = 0;
    if (!S.next(0, cur)) return;
    f32x4 acc[2][2][4][2];
#pragma unroll
    for (int a = 0; a < 2; ++a)
#pragma unroll
        for (int b = 0; b < 2; ++b)
#pragma unroll
            for (int m = 0; m < 4; ++m)
#pragma unroll
                for (int n = 0; n < 2; ++n) acc[a][b][m][n] = (f32x4){0.f, 0.f, 0.f, 0.f};
    bf16x8 At[4][2], B0[2][2], B1[2][2];
    const char* cA = (const char*)g.A + (size_t)cur.pm * tstep; const char* cB = (const char*)g.Bt + (size_t)cur.pn * tstep;
    S.a_ready(cur);
    PG8_STAGE(PG8_SB(0, 0), cB, voffB); PG8_STAGE(PG8_SA(0, 0), cA, voffA); PG8_STAGE(PG8_SB(0, 1), cB + hstep, voffB); PG8_STAGE(PG8_SA(0, 1), cA + hstep, voffA);
    if (wr == 1) PG8_BAR;
    PG8_WAIT_V(4); PG8_BAR;
    PG8_STAGE(PG8_SB(1, 0), cB + kstep, voffB); PG8_STAGE(PG8_SA(1, 0), cA + kstep, voffA); PG8_STAGE(PG8_SB(1, 1), cB + hstep + kstep, voffB);
    PG8_WAIT_V(6); PG8_BAR;
    for (;;) {
        const bool has_next = S.next(ui + 1, nxt);
        const char* nA = has_next ? (const char*)g.A + (size_t)nxt.pm * tstep : cA; const char* nB = has_next ? (const char*)g.Bt + (size_t)nxt.pn * tstep : cB;
        for (int t = 0; t < nt; t += 2) {
            const bool last = (t == nt - 2);
            const char* a1 = cA + (size_t)(t + 1) * kstep;
            const char* a2 = last ? nA : cA + (size_t)(t + 2) * kstep; const char* b2 = last ? nB : cB + (size_t)(t + 2) * kstep;
            const char* a3 = a2 + kstep; const char* b3 = b2 + kstep;
            if (last && has_next) S.a_ready(nxt);
            PG8_LDB(B0, 0, 0); PG8_SCHED; PG8_LDA(At, 0, 0); PG8_STAGE(PG8_SA(1, 1), a1 + hstep, voffA);
            PG8_WAIT_L(8); PG8_BAR; PG8_WAIT_L(0); PG8_MMA(0, 0, At, B0); PG8_BAR; PG8_SCHED;
            PG8_LDB(B1, 0, 1); PG8_STAGE(PG8_SB(0, 0), b2, voffB);
            PG8_BAR; PG8_WAIT_L(0); PG8_MMA(0, 1, At, B1); PG8_BAR;
            PG8_LDA(At, 0, 1); PG8_STAGE(PG8_SA(0, 0), a2, voffA);
            PG8_BAR; PG8_WAIT_L(0); PG8_MMA(1, 0, At, B0); PG8_BAR; PG8_SCHED;
            PG8_STAGE(PG8_SB(0, 1), b2 + hstep, voffB);
            PG8_WAIT_V(6); PG8_BAR; PG8_MMA(1, 1, At, B1); PG8_BAR;
            PG8_LDB(B0, 1, 0); PG8_SCHED; PG8_LDA(At, 1, 0); PG8_STAGE(PG8_SA(0, 1), a2 + hstep, voffA);
            PG8_WAIT_L(8); PG8_BAR; PG8_WAIT_L(0); PG8_MMA(0, 0, At, B0); PG8_BAR; PG8_SCHED;
            PG8_LDB(B1, 1, 1); PG8_STAGE(PG8_SB(1, 0), b3, voffB);
            PG8_BAR; PG8_WAIT_L(0); PG8_MMA(0, 1, At, B1); PG8_BAR;
            PG8_LDA(At, 1, 1); PG8_STAGE(PG8_SA(1, 0), a3, voffA);
            PG8_BAR; PG8_WAIT_L(0); PG8_MMA(1, 0, At, B0); PG8_BAR; PG8_SCHED;
            PG8_STAGE(PG8_SB(1, 1), b3 + hstep, voffB);
            PG8_WAIT_V(6); PG8_BAR; PG8_MMA(1, 1, At, B1); PG8_BAR;
        }
        if constexpr (!Epi::AFTER_DRAIN) { E(acc, cur, wr, wc, fr, fq); S.done(cur); }
        if (!has_next) break;
#pragma unroll
        for (int a = 0; a < 2; ++a)
#pragma unroll
            for (int b = 0; b < 2; ++b)
#pragma unroll
                for (int m = 0; m < 4; ++m)
#pragma unroll
                    for (int n = 0; n < 2; ++n) acc[a][b][m][n] = (f32x4){0.f, 0.f, 0.f, 0.f};
        cur = nxt; cA = nA; cB = nB; ++ui;
    }
    PG8_WAIT_V(0);
    if (wr == 0) PG8_BAR;
    PG8_BAR;
    if constexpr (Epi::AFTER_DRAIN) { E.fused(acc, cur, wr, wc, fr, fq, lds, wid, lane); S.done(cur); }
#undef PG8_SA
#undef PG8_SB
#undef PG8_STAGE
#undef PG8_LDA
#undef PG8_LDB
#undef PG8_MMA
#undef PG8_WAIT_V
#undef PG8_WAIT_L
#undef PG8_BAR
#undef PG8_SCHED
}
}

typedef unsigned short bf16_t;
typedef short bf16x8 __attribute__((ext_vector_type(8)));
typedef float f32x4 __attribute__((ext_vector_type(4)));
typedef float f32x16 __attribute__((ext_vector_type(16)));
typedef unsigned u32x4 __attribute__((ext_vector_type(4)));
typedef unsigned u32x2 __attribute__((ext_vector_type(2)));

constexpr int DM = 1024, NPROMPT = 32768, NSAMPLE = 1024, MROWS = NPROMPT + NSAMPLE, DIN = 3328;
constexpr int C_QA = 0, C_KA = 512, C_VA = 640, C_GA = 768, C_QR = 1280, C_KR = 1792, C_VR = 2304, C_GR = 2816;
constexpr float ALPHA = 1.189207115002721f;
constexpr size_t O_Y = 0, O_KWP = 34603008, O_VWP = 34865152, O_SP = 35127296, O_KWS = 36175872, O_VWS = 38273024, O_SS = 40370176;
constexpr size_t MiB = 1u << 20;
constexpr size_t WS_WIN = 0, WS_WOUT = 8 * MiB, WS_COND = 12 * MiB, WS_COS = 16 * MiB, WS_SIN = 17 * MiB, WS_STATS = 20 * MiB, WS_BAR = 24 * MiB,
                 WS_H = 32 * MiB, WS_Y = 32 * MiB, WS_MIX = 100 * MiB, WS_Z = 168 * MiB;
constexpr int LDS_BYTES = 155648;

__device__ __forceinline__ size_t zrow(int C, int nh, int hd, int h, size_t row) {
    const size_t tb = (size_t)MROWS * C;
    if (row < (size_t)NPROMPT) { const size_t b = row >> 11, t = row & 2047; return tb + ((b * nh + h) * 2048 + t) * hd; }
    const size_t sr = row - NPROMPT, sb = sr >> 3, st = sr & 7;
    return tb + (size_t)NPROMPT * nh * hd + ((sb * nh + h) * 8 + st) * hd;
}
__device__ __forceinline__ size_t zrow_p(int C, int nh, int hd, int h, size_t b, size_t t) { return (size_t)MROWS * C + ((b * nh + h) * 2048 + t) * hd; }
__device__ __forceinline__ size_t zrow_s(int C, int nh, int hd, int h, size_t sb, size_t st) { return (size_t)MROWS * C + (size_t)NPROMPT * nh * hd + ((sb * nh + h) * 8 + st) * hd; }
struct Params {
    const float* xp; const float* xs; const float* cp; const float* cs; const float* ck; const float* cv; const float* st;
    const float* w_ada; const float* b_ada; const float* w_in; const float* sinks; const float* gn_w; const float* w_out; const float* ln_w; const float* ln_b;
    float* out; unsigned char* ws;
};

__device__ __forceinline__ unsigned cvt_pk(float lo, float hi) { return pg8::cvt_pk_bf16(lo, hi); }
__device__ __forceinline__ float bf_lo(unsigned w) { return __uint_as_float(w << 16); }
__device__ __forceinline__ float bf_hi(unsigned w) { return __uint_as_float(w & 0xffff0000u); }
__device__ __forceinline__ float silu_f(float v) { return v * __builtin_amdgcn_rcpf(1.0f + __expf(-v)); }
__device__ __forceinline__ f32x16 mfma32(bf16x8 a, bf16x8 b, f32x16 c) { return __builtin_amdgcn_mfma_f32_32x32x16_bf16(a, b, c, 0, 0, 0); }
__device__ __forceinline__ f32x4 mfma16(bf16x8 a, bf16x8 b, f32x4 c) { return __builtin_amdgcn_mfma_f32_16x16x32_bf16(a, b, c, 0, 0, 0); }
__device__ __forceinline__ bf16x8 as_frag(u32x4 v) { return __builtin_bit_cast(bf16x8, v); }
__device__ __forceinline__ u32x4 pack8(const float* v) { u32x4 r; r.x = cvt_pk(v[0], v[1]); r.y = cvt_pk(v[2], v[3]); r.z = cvt_pk(v[4], v[5]); r.w = cvt_pk(v[6], v[7]); return r; }

struct EpiZ {
    static constexpr bool PERM = true, AFTER_DRAIN = false;
    bf16_t* Z; float* out;
    __device__ __forceinline__ void operator()(const f32x4 (&acc)[2][2][4][2], const pg8::Unit& u, int wr, int wc, int fr, int fq) const {
        const int row0 = u.pm * 256 + wr * 64 + fr;
        const bool smp = u.pm >= 128;
        bf16_t* P[2]; size_t step[2];
#pragma unroll
        for (int bj = 0; bj < 2; ++bj) {
            const int k128 = u.pn * 2 + bj;
            int C128, nh, hd;
            if (k128 < 4) { C128 = 0; nh = 8; hd = 64; } else if (k128 < 5) { C128 = 4; nh = 2; hd = 64; } else if (k128 < 6) { C128 = 5; nh = 2; hd = 64; }
            else if (k128 < 10) { C128 = 6; nh = 8; hd = 64; } else { C128 = 10 + (((k128 - 10) >> 2) << 2); nh = 4; hd = 128; }
            int h, d;
            if (hd == 128) { h = k128 - C128; d = wc * 32 + 8 * fq; } else { h = (k128 - C128) * 2 + (wc >> 1); d = (wc & 1) * 32 + 8 * fq; }
            const size_t tb = (size_t)MROWS * (size_t)(C128 * 128);
            if (!smp) { const int b = u.pm >> 3, t0 = (u.pm & 7) * 256 + wr * 64 + fr; P[bj] = Z + tb + ((size_t)(b * nh + h) * 2048 + t0) * hd + d; step[bj] = (size_t)16 * hd; }
            else { const int sr0 = (u.pm - 128) * 256 + wr * 64 + fr; P[bj] = Z + tb + (size_t)NPROMPT * nh * hd + ((size_t)((sr0 >> 3) * nh + h) * 8 + (sr0 & 7)) * hd + d; step[bj] = (size_t)16 * nh * hd; }
        }
#pragma unroll
        for (int ai = 0; ai < 2; ++ai)
#pragma unroll
            for (int m = 0; m < 4; ++m) {
                const int row = row0 + ai * 128 + m * 16;
#pragma unroll
                for (int bj = 0; bj < 2; ++bj) {
                    const f32x4 v0 = acc[ai][bj][m][0], v1 = acc[ai][bj][m][1];
                    u32x4 w; w.x = cvt_pk(v0[0], v0[1]); w.y = cvt_pk(v0[2], v0[3]); w.z = cvt_pk(v1[0], v1[1]); w.w = cvt_pk(v1[2], v1[3]);
                    *(u32x4*)(P[bj] + (size_t)(ai * 8 + m) * step[bj]) = w;
                }
                if (u.pn == 2) {
                    long base = -1;
                    size_t vofs = 0;
                    if (row < NPROMPT) { const int b = row >> 11, t = row & 2047; if (t >= 1920) { base = (long)O_KWP + (long)b * 16384 + (long)(t - 1920) * 128; vofs = O_VWP - O_KWP; } }
                    else { const int sr = row - NPROMPT, b = sr >> 3, t = sr & 7; base = (long)O_KWS + (long)b * 16384 + (long)(120 + t) * 128; vofs = O_VWS - O_KWS; }
                    if (base >= 0) {
                        const int cl = wc * 32 + 8 * fq;
#pragma unroll
                        for (int bj = 0; bj < 2; ++bj) {
                            float* dst = out + base + (bj ? vofs : 0) + cl;
                            *(f32x4*)dst = acc[ai][bj][m][0]; *(f32x4*)(dst + 4) = acc[ai][bj][m][1];
                        }
                    }
                }
            }
    }
};
struct EpiY {
    static constexpr bool PERM = true, AFTER_DRAIN = false;
    bf16_t* Y;
    __device__ __forceinline__ void operator()(const f32x4 (&acc)[2][2][4][2], const pg8::Unit& u, int wr, int wc, int fr, int fq) const {
        const int row0 = u.pm * 256 + wr * 64 + fr, col0 = u.pn * 256 + wc * 32 + 8 * fq;
#pragma unroll
        for (int ai = 0; ai < 2; ++ai)
#pragma unroll
            for (int m = 0; m < 4; ++m) {
                bf16_t* rowp = Y + (size_t)(row0 + ai * 128 + m * 16) * DM + col0;
#pragma unroll
                for (int bj = 0; bj < 2; ++bj) {
                    const f32x4 v0 = acc[ai][bj][m][0], v1 = acc[ai][bj][m][1];
                    u32x4 w; w.x = cvt_pk(v0[0], v0[1]); w.y = cvt_pk(v0[2], v0[3]); w.z = cvt_pk(v1[0], v1[1]); w.w = cvt_pk(v1[2], v1[3]);
                    *(u32x4*)(rowp + bj * 128) = w;
                }
            }
    }
};

__device__ __forceinline__ void p0_cond(const Params& p, unsigned char* lds, int nblk) {
    bf16_t* Bs = (bf16_t*)lds;
    const int tid = opaque_tid(), w = tid >> 6, lane = tid & 63, n0 = nblk * 16;
    float* cond = (float*)(p.ws + WS_COND);
    {
        float wv[32];
#pragma unroll
        for (int it = 0; it < 32; ++it) { const int idx = tid + it * 512; wv[it] = p.w_ada[(size_t)(idx >> 4) * 3072 + n0 + (idx & 15)]; }
#pragma unroll
        for (int it = 0; it < 32; ++it) { const int idx = tid + it * 512; Bs[(idx & 15) * 1032 + (idx >> 4)] = (bf16_t)(cvt_pk(wv[it], 0.f) & 0xffffu); }
    }
    __syncthreads();
    {
        f32x4 acc[9];
#pragma unroll
        for (int rt = 0; rt < 9; ++rt) acc[rt] = (f32x4){0.f, 0.f, 0.f, 0.f};
#pragma unroll
        for (int ks = 0; ks < 4; ++ks) {
            const int k0 = w * 128 + ks * 32 + (lane >> 4) * 8;
            const bf16x8 bfr = *(const bf16x8*)(Bs + (lane & 15) * 1032 + k0);
#pragma unroll
            for (int rt = 0; rt < 9; ++rt) {
                const float* crow = rt == 0 ? p.cp + (size_t)(lane & 15) * DM : p.cs + (size_t)((rt - 1) * 16 + (lane & 15)) * DM;
                const f32x4 a0 = *(const f32x4*)(crow + k0), a1 = *(const f32x4*)(crow + k0 + 4);
                u32x4 av; av.x = cvt_pk(silu_f(a0[0]), silu_f(a0[1])); av.y = cvt_pk(silu_f(a0[2]), silu_f(a0[3])); av.z = cvt_pk(silu_f(a1[0]), silu_f(a1[1])); av.w = cvt_pk(silu_f(a1[2]), silu_f(a1[3]));
                acc[rt] = mfma16(as_frag(av), bfr, acc[rt]);
            }
        }
        f32x4* part = (f32x4*)(lds + 40960);
#pragma unroll
        for (int rt = 0; rt < 9; ++rt) part[(w * 9 + rt) * 64 + lane] = acc[rt];
        __syncthreads();
        for (int t = tid; t < 576; t += 512) {
            const int rt = t >> 6, l = t & 63;
            f32x4 sum = {0.f, 0.f, 0.f, 0.f};
#pragma unroll
            for (int w2 = 0; w2 < 8; ++w2) sum += part[(w2 * 9 + rt) * 64 + l];
            const int n = n0 + (l & 15);
            const float bias = p.b_ada[n];
#pragma unroll
            for (int j = 0; j < 4; ++j) { const int r = rt * 16 + (l >> 4) * 4 + j; cond[(size_t)r * 3072 + n] = sum[j] + bias; }
        }
    }
    __syncthreads();
}
__device__ __forceinline__ void p0_tile_src(const Params& p, int t, const float*& W, bf16_t*& Wt, int& N, int& kt, int& nt) {
    if (t < 832) { W = p.w_in; Wt = (bf16_t*)(p.ws + WS_WIN); N = DIN; } else { W = p.w_out; Wt = (bf16_t*)(p.ws + WS_WOUT); N = 1024; t -= 832; }
    const int tiles_n = N / 64; kt = t / tiles_n; nt = t % tiles_n;
}
__device__ __forceinline__ void p0_transposes(const Params& p, unsigned char* lds, int t0, int nt_mine, int tstep) {
    float* T = (float*)lds;
    const int tid = opaque_tid();
    float v[8];
    if (nt_mine > 0) {
        const float* W; bf16_t* Wt; int N, kt, nt; p0_tile_src(p, t0, W, Wt, N, kt, nt);
#pragma unroll
        for (int e = 0; e < 8; ++e) { const int idx = tid + e * 512, k = idx >> 6, n = idx & 63; v[e] = W[(size_t)(kt * 64 + k) * N + nt * 64 + n]; }
    }
    for (int i = 0; i < nt_mine; ++i) {
        const int t = t0 + i * tstep;
        const float* W; bf16_t* Wt; int N, kt, nt; p0_tile_src(p, t, W, Wt, N, kt, nt);
#pragma unroll
        for (int e = 0; e < 8; ++e) { const int idx = tid + e * 512, k = idx >> 6, n = idx & 63; T[k * 65 + n] = v[e]; }
        lds_barrier();
        if (i + 1 < nt_mine) {
            const float* W2; bf16_t* Wt2; int N2, kt2, nt2; p0_tile_src(p, t + tstep, W2, Wt2, N2, kt2, nt2);
#pragma unroll
            for (int e = 0; e < 8; ++e) { const int idx = tid + e * 512, k = idx >> 6, n = idx & 63; v[e] = W2[(size_t)(kt2 * 64 + k) * N2 + nt2 * 64 + n]; }
        }
#pragma unroll
        for (int e = 0; e < 4; ++e) { const int idx = tid + e * 512, n = idx >> 5, k = (idx & 31) * 2;
            *(unsigned*)(Wt + (size_t)(nt * 64 + n) * 1024 + kt * 64 + k) = cvt_pk(T[k * 65 + n], T[(k + 1) * 65 + n]); }
        lds_barrier();
    }
}
__device__ __forceinline__ void p0_prologue(const Params& p, unsigned char* lds) {
    const int tid = threadIdx.x, G = gridDim.x, bx = blockIdx.x;
    if (G == 256) {
        if (bx < 192) { p0_cond(p, lds, bx); p0_transposes(p, lds, bx, 4, 192); }
        else p0_transposes(p, lds, 768 + (bx - 192), 5, 64);
    } else {
        for (int nb = bx; nb < 192; nb += G) p0_cond(p, lds, nb);
        int cnt = 0; for (int t = bx; t < 1088; t += G) ++cnt;
        p0_transposes(p, lds, bx, cnt, G);
    }
    float* tc = (float*)(p.ws + WS_COS); float* tsn = (float*)(p.ws + WS_SIN);
    for (int idx = bx * 512 + tid; idx < 2056 * 64; idx += G * 512) {
        const int r = idx >> 6, d = idx & 63;
        const float pos = (float)(r < 2048 ? r : 16384 + (r - 2048));
        const float inv = powf(10000.0f, -(float)d / 64.0f);
        const float ang = pos * inv;
        const double a = (double)ang;
        const double nrev = rint(a * 0.15915494309189535);
        const float red = (float)(a - nrev * 6.283185307179586);
        tc[idx] = __cosf(red); tsn[idx] = __sinf(red);
    }
    {
        const int NV = 128 * 3840, stride = G * 512;
        for (int base = bx * 512 + tid; base < NV; base += 4 * stride) {
            f32x4 kv[4], vv[4];
#pragma unroll
            for (int u = 0; u < 4; ++u) { const int idx = base + u * stride; if (idx < NV) { const int b = idx / 3840, e = (idx % 3840) * 4;
                kv[u] = __builtin_nontemporal_load((const f32x4*)(p.ck + (size_t)b * 16384 + 1024 + e)); vv[u] = __builtin_nontemporal_load((const f32x4*)(p.cv + (size_t)b * 16384 + 1024 + e)); } }
#pragma unroll
            for (int u = 0; u < 4; ++u) { const int idx = base + u * stride; if (idx < NV) { const int b = idx / 3840, e = (idx % 3840) * 4;
                *(f32x4*)(p.out + O_KWS + (size_t)b * 16384 + e) = kv[u]; *(f32x4*)(p.out + O_VWS + (size_t)b * 16384 + e) = vv[u]; } }
        }
    }
}
__device__ __forceinline__ void p1a_modulate(const Params& p) {
    const float* cond = (const float*)(p.ws + WS_COND);
    bf16_t* H = (bf16_t*)(p.ws + WS_H);
    const size_t NIT = (size_t)MROWS * 128, stride = (size_t)gridDim.x * 512;
    for (size_t base = (size_t)blockIdx.x * 512 + threadIdx.x; base < NIT; base += 4 * stride) {
        f32x4 x0[4], x1[4], sh0[4], sh1[4], sc0[4], sc1[4];
#pragma unroll
        for (int u = 0; u < 4; ++u) {
            const size_t it = base + u * stride;
            if (it < NIT) {
                const int row = (int)(it >> 7), c8 = (int)(it & 127) * 8;
                const float* xr = row < NPROMPT ? p.xp + (size_t)row * DM : p.xs + (size_t)(row - NPROMPT) * DM;
                const int crow = row < NPROMPT ? (row >> 11) : 16 + ((row - NPROMPT) >> 3);
                const float* cr = cond + (size_t)crow * 3072;
                x0[u] = __builtin_nontemporal_load((const f32x4*)(xr + c8)); x1[u] = __builtin_nontemporal_load((const f32x4*)(xr + c8 + 4));
                sh0[u] = *(const f32x4*)(cr + c8); sh1[u] = *(const f32x4*)(cr + c8 + 4);
                sc0[u] = *(const f32x4*)(cr + 1024 + c8); sc1[u] = *(const f32x4*)(cr + 1024 + c8 + 4);
            }
        }
#pragma unroll
        for (int u = 0; u < 4; ++u) {
            const size_t it = base + u * stride;
            if (it < NIT) {
                const int row = (int)(it >> 7), c8 = (int)(it & 127) * 8;
                const f32x4 h0 = x0[u] * (sc0[u] + 1.0f) + sh0[u], h1 = x1[u] * (sc1[u] + 1.0f) + sh1[u];
                u32x4 w; w.x = cvt_pk(h0[0], h0[1]); w.y = cvt_pk(h0[2], h0[3]); w.z = cvt_pk(h1[0], h1[1]); w.w = cvt_pk(h1[2], h1[3]);
                *(u32x4*)(H + (size_t)row * DM + c8) = w;
            }
        }
    }
}
__device__ __forceinline__ void p4_layernorm(const Params& p) {
    const float* cond = (const float*)(p.ws + WS_COND);
    const bf16_t* Y = (const bf16_t*)(p.ws + WS_Y);
    const int w = threadIdx.x >> 6, lane = threadIdx.x & 63;
    for (int row0 = (blockIdx.x * 8 + w) * 2; row0 < MROWS; row0 += gridDim.x * 16) {
        f32x4 r[2][4];
#pragma unroll
        for (int rr = 0; rr < 2; ++rr) {
            const int row = row0 + rr;
            const float* xr = row < NPROMPT ? p.xp + (size_t)row * DM : p.xs + (size_t)(row - NPROMPT) * DM;
            const int crow = row < NPROMPT ? (row >> 11) : 16 + ((row - NPROMPT) >> 3);
            const float* gr = cond + (size_t)crow * 3072 + 2048;
            const bf16_t* yr = Y + (size_t)row * DM;
#pragma unroll
            for (int i = 0; i < 4; ++i) {
                const int c = (i * 64 + lane) * 4;
                const f32x4 xv = *(const f32x4*)(xr + c), gv = *(const f32x4*)(gr + c);
                const u32x2 yw = *(const u32x2*)(yr + c);
                f32x4 yv; yv[0] = bf_lo(yw.x); yv[1] = bf_hi(yw.x); yv[2] = bf_lo(yw.y); yv[3] = bf_hi(yw.y);
                r[rr][i] = xv * ALPHA + gv * yv;
            }
        }
#pragma unroll
        for (int rr = 0; rr < 2; ++rr) {
            float s = 0.f;
#pragma unroll
            for (int i = 0; i < 4; ++i) s += (r[rr][i][0] + r[rr][i][1]) + (r[rr][i][2] + r[rr][i][3]);
#pragma unroll
            for (int o = 1; o < 64; o <<= 1) s += __shfl_xor(s, o);
            const float mu = s * (1.0f / 1024.0f);
            float q = 0.f;
#pragma unroll
            for (int i = 0; i < 4; ++i) { const f32x4 d = r[rr][i] - mu; q += (d[0] * d[0] + d[1] * d[1]) + (d[2] * d[2] + d[3] * d[3]); }
#pragma unroll
            for (int o = 1; o < 64; o <<= 1) q += __shfl_xor(q, o);
            const float rstd = rsqrtf(q * (1.0f / 1024.0f) + 1e-5f);
            float* o = p.out + (size_t)(row0 + rr) * DM;
#pragma unroll
            for (int i = 0; i < 4; ++i) {
                const int c = (i * 64 + lane) * 4;
                const f32x4 lw = *(const f32x4*)(p.ln_w + c), lb = *(const f32x4*)(p.ln_b + c);
                *(f32x4*)(o + c) = (r[rr][i] - mu) * rstd * lw + lb;
            }
        }
    }
}

constexpr int R_QS = 0, R_KS = 17408, R_KT = 34816, R_VT = 55296, R_AS = 75776, R_ST = 84992, R_OB = 119808;
constexpr int LDQ = 136, LDT = 80, LDA = 72, LDO = 132;

__device__ __forceinline__ void ret_write_st(bf16_t* St, const f32x16 (&Sacc)[2], int kt0, int ct, int l31, int hh) {
#pragma unroll
    for (int t2 = 0; t2 < 2; ++t2)
#pragma unroll
        for (int g4 = 0; g4 < 4; ++g4) {
            const int dk0 = (kt0 + t2) * 32 + 8 * g4 + 4 * hh, dv = ct * 32 + l31;
            u32x2 w; w.x = cvt_pk(Sacc[t2][4 * g4 + 0], Sacc[t2][4 * g4 + 1]); w.y = cvt_pk(Sacc[t2][4 * g4 + 2], Sacc[t2][4 * g4 + 3]);
            *(u32x2*)(St + dv * LDQ + dk0) = w;
        }
}

template <bool SAMPLE>
__device__ __forceinline__ void ret_item(const Params& p, unsigned char* lds, int b, int h) {
    bf16_t* Qs = (bf16_t*)(lds + R_QS); bf16_t* Ks = (bf16_t*)(lds + R_KS); bf16_t* Kt = (bf16_t*)(lds + R_KT); bf16_t* Vt = (bf16_t*)(lds + R_VT);
    bf16_t* As = (bf16_t*)(lds + R_AS); bf16_t* St = (bf16_t*)(lds + R_ST); float* Ob = (float*)(lds + R_OB);
    const bf16_t* Z = (const bf16_t*)(p.ws + WS_Z);
    bf16_t* MX = (bf16_t*)(p.ws + WS_MIX);
    const float* tcs = (const float*)(p.ws + WS_COS); const float* tsn = (const float*)(p.ws + WS_SIN);
    const int tid = opaque_tid(), w = tid >> 6, lane = tid & 63, l31 = lane & 31, hh = lane >> 5;
    const float lg = logf(1.0f - exp2f(-5.0f - (float)h));
    const int nchunk = SAMPLE ? 1 : 32;
    const float gL = expf(lg * (SAMPLE ? 8.0f : 64.0f));
    const size_t rowbase = SAMPLE ? (size_t)NPROMPT + (size_t)b * 8 : (size_t)b * 2048;
    const int ct = w & 3, kt0 = (w >> 2) * 2, rt = w >> 2;
    const int si = lane, sd0 = w * 8, sdv0 = w * 16;
    const bool svalid = !SAMPLE || si < 8;
    const float qd = expf(lg * (float)(si + 1)), kd = expf(-lg * (float)(si + 1)) * 0.08838834764831845f;
    const int gi = tid >> 3, gdv0 = (tid & 7) * 16;
    float gwv[16];
#pragma unroll
    for (int e = 0; e < 16; ++e) gwv[e] = p.gn_w[h * 128 + gdv0 + e];
    u32x4 q1, q2, k1, k2, v1, v2, gn1, gn2, gc1, gc2; f32x4 c0, c1, s0, s1;
#define RET_LOAD(cc) do { \
        const size_t _row = rowbase + (size_t)(cc) * 64 + (SAMPLE ? (si & 7) : si); \
        const int _trow = SAMPLE ? 2048 + (si & 7) : (cc) * 64 + si; \
        const size_t _zo = SAMPLE ? zrow_s(0, 4, 128, h, b, si & 7) : zrow_p(0, 4, 128, h, b, (size_t)(cc) * 64 + si); \
        const bf16_t* _zq = Z + (size_t)MROWS * C_QR + _zo; const bf16_t* _zk = Z + (size_t)MROWS * C_KR + _zo; const bf16_t* _zv = Z + (size_t)MROWS * C_VR + _zo; \
        q1 = *(const u32x4*)(_zq + sd0); q2 = *(const u32x4*)(_zq + 64 + sd0); \
        k1 = *(const u32x4*)(_zk + sd0); k2 = *(const u32x4*)(_zk + 64 + sd0); \
        v1 = *(const u32x4*)(_zv + sdv0); v2 = *(const u32x4*)(_zv + sdv0 + 8); \
        c0 = *(const f32x4*)(tcs + _trow * 64 + sd0); c1 = *(const f32x4*)(tcs + _trow * 64 + sd0 + 4); \
        s0 = *(const f32x4*)(tsn + _trow * 64 + sd0); s1 = *(const f32x4*)(tsn + _trow * 64 + sd0 + 4); \
        const size_t _grow = rowbase + (size_t)(cc) * 64 + (SAMPLE ? (gi & 7) : gi); \
        const bf16_t* _gp = Z + (SAMPLE ? zrow_s(C_GR, 4, 128, h, b, gi & 7) : zrow_p(C_GR, 4, 128, h, b, (size_t)(cc) * 64 + gi)) + gdv0; \
        gn1 = *(const u32x4*)_gp; gn2 = *(const u32x4*)(_gp + 8); } while (0)
    RET_LOAD(0);
    f32x16 Sacc[2];
    if (SAMPLE) {
        const float* sp = p.st + (size_t)(b * 4 + h) * 16384;
#pragma unroll
        for (int t2 = 0; t2 < 2; ++t2)
#pragma unroll
            for (int r = 0; r < 16; ++r) { const int dk = (kt0 + t2) * 32 + (r & 3) + 8 * (r >> 2) + 4 * hh; Sacc[t2][r] = sp[dk * 128 + ct * 32 + l31]; }
    } else {
#pragma unroll
        for (int t2 = 0; t2 < 2; ++t2)
#pragma unroll
            for (int r = 0; r < 16; ++r) Sacc[t2][r] = 0.f;
    }
    ret_write_st(St, Sacc, kt0, ct, l31, hh);
    for (int c = 0; c < nchunk; ++c) {
        {
            float qa[8], qb[8], ka[8], kb[8];
#pragma unroll
            for (int e = 0; e < 4; ++e) {
                const unsigned wq1 = q1[e], wq2 = q2[e], wk1 = k1[e], wk2 = k2[e];
#pragma unroll
                for (int hf = 0; hf < 2; ++hf) {
                    const int ee = e * 2 + hf;
                    const float cs = ee < 4 ? c0[ee & 3] : c1[ee & 3], sn = ee < 4 ? s0[ee & 3] : s1[ee & 3];
                    const float x1 = hf ? bf_hi(wq1) : bf_lo(wq1), x2 = hf ? bf_hi(wq2) : bf_lo(wq2);
                    const float y1 = hf ? bf_hi(wk1) : bf_lo(wk1), y2 = hf ? bf_hi(wk2) : bf_lo(wk2);
                    qa[ee] = svalid ? (x1 * cs - x2 * sn) * qd : 0.f; qb[ee] = svalid ? (x2 * cs + x1 * sn) * qd : 0.f;
                    ka[ee] = svalid ? (y1 * cs - y2 * sn) * kd : 0.f; kb[ee] = svalid ? (y2 * cs + y1 * sn) * kd : 0.f;
                }
            }
            const u32x4 pqa = pack8(qa), pqb = pack8(qb), pka = pack8(ka), pkb = pack8(kb);
            *(u32x4*)(Qs + si * LDQ + sd0) = pqa; *(u32x4*)(Qs + si * LDQ + 64 + sd0) = pqb;
            *(u32x4*)(Ks + si * LDQ + sd0) = pka; *(u32x4*)(Ks + si * LDQ + 64 + sd0) = pkb;
#pragma unroll
            for (int e = 0; e < 4; ++e) {
                Kt[(sd0 + 2 * e) * LDT + si] = (bf16_t)(pka[e] & 0xffffu); Kt[(sd0 + 2 * e + 1) * LDT + si] = (bf16_t)(pka[e] >> 16);
                Kt[(64 + sd0 + 2 * e) * LDT + si] = (bf16_t)(pkb[e] & 0xffffu); Kt[(64 + sd0 + 2 * e + 1) * LDT + si] = (bf16_t)(pkb[e] >> 16);
            }
            if (!svalid) { v1 = (u32x4){0u, 0u, 0u, 0u}; v2 = v1; }
#pragma unroll
            for (int e = 0; e < 4; ++e) {
                Vt[(sdv0 + 2 * e) * LDT + si] = (bf16_t)(v1[e] & 0xffffu); Vt[(sdv0 + 2 * e + 1) * LDT + si] = (bf16_t)(v1[e] >> 16);
                Vt[(sdv0 + 8 + 2 * e) * LDT + si] = (bf16_t)(v2[e] & 0xffffu); Vt[(sdv0 + 8 + 2 * e + 1) * LDT + si] = (bf16_t)(v2[e] >> 16);
            }
            gc1 = gn1; gc2 = gn2;
        }
        if (c + 1 < nchunk) RET_LOAD(c + 1);
        lds_barrier();
#pragma unroll
        for (int tq = 0; tq < 2; ++tq) {
            const int tt = w + tq * 8, jt = tt >> 2, it = tt & 3;
            f32x4 a4 = {0.f, 0.f, 0.f, 0.f};
            if (it >= jt) {
#pragma unroll
                for (int kk = 0; kk < 4; ++kk) {
                    const bf16x8 af = *(const bf16x8*)(Ks + (jt * 16 + (lane & 15)) * LDQ + kk * 32 + (lane >> 4) * 8);
                    const bf16x8 bfr = *(const bf16x8*)(Qs + (it * 16 + (lane & 15)) * LDQ + kk * 32 + (lane >> 4) * 8);
                    a4 = mfma16(af, bfr, a4);
                }
            }
            const int i = it * 16 + (lane & 15), j0 = jt * 16 + 4 * (lane >> 4);
            u32x2 wv; wv.x = cvt_pk(i >= j0 ? a4[0] : 0.f, i >= j0 + 1 ? a4[1] : 0.f); wv.y = cvt_pk(i >= j0 + 2 ? a4[2] : 0.f, i >= j0 + 3 ? a4[3] : 0.f);
            *(u32x2*)(As + i * LDA + j0) = wv;
        }
        lds_barrier();
        {
            f32x16 O;
#pragma unroll
            for (int r = 0; r < 16; ++r) O[r] = 0.f;
            bf16x8 vf[4];
#pragma unroll
            for (int ks = 0; ks < 4; ++ks) vf[ks] = *(const bf16x8*)(Vt + (ct * 32 + l31) * LDT + ks * 16 + 8 * hh);
#pragma unroll
            for (int ks = 0; ks < 4; ++ks) { const bf16x8 af = *(const bf16x8*)(As + (rt * 32 + l31) * LDA + ks * 16 + 8 * hh); O = mfma32(af, vf[ks], O); }
#pragma unroll
            for (int ks = 0; ks < 8; ++ks) {
                const bf16x8 af = *(const bf16x8*)(Qs + (rt * 32 + l31) * LDQ + ks * 16 + 8 * hh);
                const bf16x8 bfr = *(const bf16x8*)(St + (ct * 32 + l31) * LDQ + ks * 16 + 8 * hh);
                O = mfma32(af, bfr, O);
            }
#pragma unroll
            for (int t2 = 0; t2 < 2; ++t2) {
#pragma unroll
                for (int ks = 0; ks < 4; ++ks) { const bf16x8 af = *(const bf16x8*)(Kt + ((kt0 + t2) * 32 + l31) * LDT + ks * 16 + 8 * hh); Sacc[t2] = mfma32(af, vf[ks], Sacc[t2]); }
#pragma unroll
                for (int r = 0; r < 16; ++r) Sacc[t2][r] *= gL;
            }
#pragma unroll
            for (int r = 0; r < 16; ++r) { const int i = rt * 32 + (r & 3) + 8 * (r >> 2) + 4 * hh; Ob[i * LDO + ct * 32 + l31] = O[r]; }
        }
        lds_barrier();
        if (c + 1 < nchunk) ret_write_st(St, Sacc, kt0, ct, l31, hh);
        {
            float o[16];
#pragma unroll
            for (int e4 = 0; e4 < 4; ++e4) { const f32x4 v = *(const f32x4*)(Ob + gi * LDO + gdv0 + e4 * 4); o[e4 * 4] = v[0]; o[e4 * 4 + 1] = v[1]; o[e4 * 4 + 2] = v[2]; o[e4 * 4 + 3] = v[3]; }
            float s = 0.f;
#pragma unroll
            for (int e = 0; e < 16; ++e) s += o[e];
            s += __shfl_xor(s, 1); s += __shfl_xor(s, 2); s += __shfl_xor(s, 4);
            const float mu = s * (1.0f / 128.0f);
            float q = 0.f;
#pragma unroll
            for (int e = 0; e < 16; ++e) { const float d = o[e] - mu; q += d * d; }
            q += __shfl_xor(q, 1); q += __shfl_xor(q, 2); q += __shfl_xor(q, 4);
            const float rstd = rsqrtf(q * (1.0f / 128.0f) + 1e-5f);
            if (!SAMPLE || gi < 8) {
                const size_t row = rowbase + (size_t)c * 64 + gi;
                float r8[16];
#pragma unroll
                for (int e = 0; e < 8; ++e) {
                    const unsigned wg = e < 4 ? gc1[e & 3] : gc2[e & 3];
                    const float ga = bf_lo(wg), gb = bf_hi(wg);
                    r8[2 * e] = (o[2 * e] - mu) * rstd * gwv[2 * e] * silu_f(ga);
                    r8[2 * e + 1] = (o[2 * e + 1] - mu) * rstd * gwv[2 * e + 1] * silu_f(gb);
                }
                bf16_t* mp = MX + row * DM + 512 + h * 128 + gdv0;
                *(u32x4*)mp = pack8(r8); *(u32x4*)(mp + 8) = pack8(r8 + 8);
            }
        }
    }
#undef RET_LOAD
    float* dst = p.out + (SAMPLE ? O_SS : O_SP) + (size_t)(b * 4 + h) * 16384;
#pragma unroll
    for (int t2 = 0; t2 < 2; ++t2)
#pragma unroll
        for (int r = 0; r < 16; ++r) { const int dk = (kt0 + t2) * 32 + (r & 3) + 8 * (r >> 2) + 4 * hh; dst[dk * 128 + ct * 32 + l31] = Sacc[t2][r]; }
    lds_barrier();
}

constexpr size_t WS_SC = 400 * MiB;
__device__ __forceinline__ void ret_chain(const Params& p, unsigned char* lds, int b, int h) {
    const bf16_t* Z = (const bf16_t*)(p.ws + WS_Z);
    const float* tcs = (const float*)(p.ws + WS_COS); const float* tsn = (const float*)(p.ws + WS_SIN);
    const int tid = opaque_tid(), w = tid >> 6, lane = tid & 63, l31 = lane & 31, hh = lane >> 5;
    const float lg = __logf(1.0f - exp2f(-5.0f - (float)h));
    const float gL = expf(lg * 64.0f);
    const int ct = w & 3, kt0 = (w >> 2) * 2;
    const int si = tid >> 3, sd0 = (tid & 7) * 8, srot = (tid & 7) * 8;
    const int sc = (si + srot) & 63;
    const float kd = __expf(-lg * (float)(si + 1)) * 0.08838834764831845f;
    u32x2* SC = (u32x2*)(p.ws + WS_SC) + (size_t)(b * 4 + h) * 32 * 4096;
    f32x16 Sacc[2];
#pragma unroll
    for (int t2 = 0; t2 < 2; ++t2)
#pragma unroll
        for (int r = 0; r < 16; ++r) Sacc[t2][r] = 0.f;
    u32x4 k1A, k2A, v1A, v2A, k1B, k2B, v1B, v2B; f32x4 c0A, c1A, s0A, s1A, c0B, c1B, s0B, s1B;
#define CH_LOAD(cc, X) do { \
        const size_t _row = (size_t)b * 2048 + (size_t)(cc) * 64 + si; const int _trow = (cc) * 64 + si; \
        const size_t _zo = zrow_p(0, 4, 128, h, b, (size_t)(cc) * 64 + si); const bf16_t* _zk = Z + (size_t)MROWS * C_KR + _zo; const bf16_t* _zv = Z + (size_t)MROWS * C_VR + _zo; \
        k1##X = *(const u32x4*)(_zk + sd0); k2##X = *(const u32x4*)(_zk + 64 + sd0); \
        v1##X = *(const u32x4*)(_zv + sd0); v2##X = *(const u32x4*)(_zv + 64 + sd0); \
        c0##X = *(const f32x4*)(tcs + _trow * 64 + sd0); c1##X = *(const f32x4*)(tcs + _trow * 64 + sd0 + 4); \
        s0##X = *(const f32x4*)(tsn + _trow * 64 + sd0); s1##X = *(const f32x4*)(tsn + _trow * 64 + sd0 + 4); } while (0)
#define CH_STORE(bufi, X) do { \
        bf16_t* _Kt = (bf16_t*)(lds + (bufi) * 40960); bf16_t* _Vt = (bf16_t*)(lds + (bufi) * 40960 + 20480); \
        float ka[8], kb[8]; \
        _Pragma("unroll") for (int e = 0; e < 4; ++e) { const unsigned wk1 = k1##X[e], wk2 = k2##X[e]; \
            _Pragma("unroll") for (int hf = 0; hf < 2; ++hf) { const int ee = e * 2 + hf; \
                const float cs = ee < 4 ? c0##X[ee & 3] : c1##X[ee & 3], sn = ee < 4 ? s0##X[ee & 3] : s1##X[ee & 3]; \
                const float y1 = hf ? bf_hi(wk1) : bf_lo(wk1), y2 = hf ? bf_hi(wk2) : bf_lo(wk2); \
                ka[ee] = (y1 * cs - y2 * sn) * kd; kb[ee] = (y2 * cs + y1 * sn) * kd; } } \
        const u32x4 pka = pack8(ka), pkb = pack8(kb); \
        _Pragma("unroll") for (int e = 0; e < 4; ++e) { \
            _Kt[(sd0 + 2 * e) * LDT + sc] = (bf16_t)(pka[e] & 0xffffu); _Kt[(sd0 + 2 * e + 1) * LDT + sc] = (bf16_t)(pka[e] >> 16); \
            _Kt[(64 + sd0 + 2 * e) * LDT + sc] = (bf16_t)(pkb[e] & 0xffffu); _Kt[(64 + sd0 + 2 * e + 1) * LDT + sc] = (bf16_t)(pkb[e] >> 16); \
            _Vt[(sd0 + 2 * e) * LDT + sc] = (bf16_t)(v1##X[e] & 0xffffu); _Vt[(sd0 + 2 * e + 1) * LDT + sc] = (bf16_t)(v1##X[e] >> 16); \
            _Vt[(64 + sd0 + 2 * e) * LDT + sc] = (bf16_t)(v2##X[e] & 0xffffu); _Vt[(64 + sd0 + 2 * e + 1) * LDT + sc] = (bf16_t)(v2##X[e] >> 16); } } while (0)
#define CH_STEP(c, X) do { \
        lds_barrier(); \
        { u32x2* dst = SC + (size_t)(((c) + 31) & 31) * 4096 + (size_t)w * 512 + lane; \
          _Pragma("unroll") for (int t2 = 0; t2 < 2; ++t2) _Pragma("unroll") for (int g4 = 0; g4 < 4; ++g4) { \
              u32x2 wv; wv.x = cvt_pk(Sacc[t2][4 * g4 + 0], Sacc[t2][4 * g4 + 1]); wv.y = cvt_pk(Sacc[t2][4 * g4 + 2], Sacc[t2][4 * g4 + 3]); \
              dst[(t2 * 4 + g4) * 64] = wv; } } \
        CH_STORE(((c) + 1) & 1, X); \
        { const int cn = (c) + 3 < 32 ? (c) + 3 : 31; CH_LOAD(cn, X); } \
        asm volatile("" ::: "memory"); __builtin_amdgcn_sched_barrier(0); \
        { const bf16_t* Kt = (const bf16_t*)(lds + ((c) & 1) * 40960); const bf16_t* Vt = (const bf16_t*)(lds + ((c) & 1) * 40960 + 20480); \
          bf16x8 vf[4]; \
          _Pragma("unroll") for (int ks = 0; ks < 4; ++ks) vf[ks] = *(const bf16x8*)(Vt + (ct * 32 + l31) * LDT + ((ks * 16 + 8 * hh + 8 * (((ct * 32 + l31) >> 3) & 7)) & 63)); \
          _Pragma("unroll") for (int t2 = 0; t2 < 2; ++t2) { \
              _Pragma("unroll") for (int ks = 0; ks < 4; ++ks) { const bf16x8 af = *(const bf16x8*)(Kt + ((kt0 + t2) * 32 + l31) * LDT + ((ks * 16 + 8 * hh + 8 * ((((kt0 + t2) * 32 + l31) >> 3) & 7)) & 63)); Sacc[t2] = mfma32(af, vf[ks], Sacc[t2]); } \
              _Pragma("unroll") for (int r = 0; r < 16; ++r) Sacc[t2][r] *= gL; } } } while (0)
    CH_LOAD(0, A);
    CH_STORE(0, A);
    CH_LOAD(1, A);
    CH_LOAD(2, B);
    for (int c = 0; c < 32; c += 2) {
        CH_STEP(c, A);
        CH_STEP(c + 1, B);
    }
#undef CH_LOAD
#undef CH_STORE
#undef CH_STEP
    float* dst = p.out + O_SP + (size_t)(b * 4 + h) * 16384;
#pragma unroll
    for (int t2 = 0; t2 < 2; ++t2)
#pragma unroll
        for (int r = 0; r < 16; ++r) { const int dk = (kt0 + t2) * 32 + (r & 3) + 8 * (r >> 2) + 4 * hh; dst[dk * 128 + ct * 32 + l31] = Sacc[t2][r]; }
    lds_barrier();
}

__device__ __forceinline__ void p2b_ret_out(const Params& p, unsigned char* lds) {
    bf16_t* Qs = (bf16_t*)(lds + R_QS); bf16_t* Ks = (bf16_t*)(lds + R_KS); bf16_t* Vt = (bf16_t*)(lds + R_VT);
    bf16_t* As = (bf16_t*)(lds + R_AS); bf16_t* St = (bf16_t*)(lds + R_ST); float* Ob = (float*)(lds + R_OB);
    const bf16_t* Z = (const bf16_t*)(p.ws + WS_Z);
    bf16_t* MX = (bf16_t*)(p.ws + WS_MIX);
    const float* tcs = (const float*)(p.ws + WS_COS); const float* tsn = (const float*)(p.ws + WS_SIN);
    const int tid = opaque_tid(), w = tid >> 6, lane = tid & 63, l31 = lane & 31, hh = lane >> 5;
    const int ct = w & 3, kt0 = (w >> 2) * 2, rt = w >> 2;
    const int si = tid >> 3, sd0 = (tid & 7) * 8, sc = (si + (tid & 7) * 8) & 63;
    const int gi = tid >> 3, gdv0 = (tid & 7) * 16;
    const int G = gridDim.x;
    u32x4 q1, q2, k1, k2, v1, v2, gn1, gn2; f32x4 c0, c1, s0, s1, gwn0, gwn1, gwn2, gwn3; u32x2 sfr[8];
#define OUT_LOAD(itv) do { \
        const int _b = (itv) >> 7, _h = ((itv) >> 5) & 3, _c = (itv) & 31; \
        const size_t _zo = zrow_p(0, 4, 128, _h, _b, (size_t)_c * 64 + si); const int _trow = _c * 64 + si; \
        const bf16_t* _zq = Z + (size_t)MROWS * C_QR + _zo; const bf16_t* _zk = Z + (size_t)MROWS * C_KR + _zo; const bf16_t* _zv = Z + (size_t)MROWS * C_VR + _zo; \
        q1 = *(const u32x4*)(_zq + sd0); q2 = *(const u32x4*)(_zq + 64 + sd0); \
        k1 = *(const u32x4*)(_zk + sd0); k2 = *(const u32x4*)(_zk + 64 + sd0); \
        v1 = *(const u32x4*)(_zv + sd0); v2 = *(const u32x4*)(_zv + 64 + sd0); \
        c0 = *(const f32x4*)(tcs + _trow * 64 + sd0); c1 = *(const f32x4*)(tcs + _trow * 64 + sd0 + 4); \
        s0 = *(const f32x4*)(tsn + _trow * 64 + sd0); s1 = *(const f32x4*)(tsn + _trow * 64 + sd0 + 4); \
        const bf16_t* _gp = Z + zrow_p(C_GR, 4, 128, _h, _b, (size_t)_c * 64 + gi) + gdv0; \
        gn1 = *(const u32x4*)_gp; gn2 = *(const u32x4*)(_gp + 8); \
        const float* _gw = p.gn_w + _h * 128 + gdv0; \
        gwn0 = *(const f32x4*)_gw; gwn1 = *(const f32x4*)(_gw + 4); gwn2 = *(const f32x4*)(_gw + 8); gwn3 = *(const f32x4*)(_gw + 12); \
        if (_c > 0) { const u32x2* _src = (const u32x2*)(p.ws + WS_SC) + ((size_t)(_b * 4 + _h) * 32 + (_c - 1)) * 4096 + (size_t)w * 512 + lane; \
            _Pragma("unroll") for (int f = 0; f < 8; ++f) sfr[f] = _src[f * 64]; } \
        else { _Pragma("unroll") for (int f = 0; f < 8; ++f) sfr[f] = (u32x2){0u, 0u}; } } while (0)
    int it = blockIdx.x;
    if (it < 2048) OUT_LOAD(it);
    for (; it < 2048; it += G) {
        const int b = it >> 7, h = (it >> 5) & 3, c = it & 31;
        const float lg = __logf(1.0f - exp2f(-5.0f - (float)h));
        const float qd = __expf(lg * (float)(si + 1)), kd = __expf(-lg * (float)(si + 1)) * 0.08838834764831845f;
        {
            float qa[8], qb[8], ka[8], kb[8];
#pragma unroll
            for (int e = 0; e < 4; ++e) {
                const unsigned wq1 = q1[e], wq2 = q2[e], wk1 = k1[e], wk2 = k2[e];
#pragma unroll
                for (int hf = 0; hf < 2; ++hf) {
                    const int ee = e * 2 + hf;
                    const float cs = ee < 4 ? c0[ee & 3] : c1[ee & 3], sn = ee < 4 ? s0[ee & 3] : s1[ee & 3];
                    const float x1 = hf ? bf_hi(wq1) : bf_lo(wq1), x2 = hf ? bf_hi(wq2) : bf_lo(wq2);
                    const float y1 = hf ? bf_hi(wk1) : bf_lo(wk1), y2 = hf ? bf_hi(wk2) : bf_lo(wk2);
                    qa[ee] = (x1 * cs - x2 * sn) * qd; qb[ee] = (x2 * cs + x1 * sn) * qd;
                    ka[ee] = (y1 * cs - y2 * sn) * kd; kb[ee] = (y2 * cs + y1 * sn) * kd;
                }
            }
            *(u32x4*)(Qs + si * LDQ + sd0) = pack8(qa); *(u32x4*)(Qs + si * LDQ + 64 + sd0) = pack8(qb);
            *(u32x4*)(Ks + si * LDQ + sd0) = pack8(ka); *(u32x4*)(Ks + si * LDQ + 64 + sd0) = pack8(kb);
#pragma unroll
            for (int e = 0; e < 4; ++e) {
                Vt[(sd0 + 2 * e) * LDT + sc] = (bf16_t)(v1[e] & 0xffffu); Vt[(sd0 + 2 * e + 1) * LDT + sc] = (bf16_t)(v1[e] >> 16);
                Vt[(64 + sd0 + 2 * e) * LDT + sc] = (bf16_t)(v2[e] & 0xffffu); Vt[(64 + sd0 + 2 * e + 1) * LDT + sc] = (bf16_t)(v2[e] >> 16);
            }
#pragma unroll
            for (int t2 = 0; t2 < 2; ++t2)
#pragma unroll
                for (int g4 = 0; g4 < 4; ++g4) { const int dk0 = (kt0 + t2) * 32 + 8 * g4 + 4 * hh, dv = ct * 32 + l31; *(u32x2*)(St + dv * LDQ + dk0) = sfr[t2 * 4 + g4]; }
        }
        const u32x4 gc1 = gn1, gc2 = gn2; const f32x4 gw0 = gwn0, gw1 = gwn1, gw2 = gwn2, gw3 = gwn3;
        { const int nit = it + G; if (nit < 2048) OUT_LOAD(nit); }
        asm volatile("" ::: "memory"); __builtin_amdgcn_sched_barrier(0);
        lds_barrier();
#pragma unroll
        for (int tq = 0; tq < 2; ++tq) {
            const int tt = w + tq * 8, jt = tt >> 2, itl = tt & 3;
            f32x4 a4 = {0.f, 0.f, 0.f, 0.f};
            if (itl >= jt) {
#pragma unroll
                for (int kk = 0; kk < 4; ++kk) {
                    const bf16x8 af = *(const bf16x8*)(Ks + (jt * 16 + (lane & 15)) * LDQ + kk * 32 + (lane >> 4) * 8);
                    const bf16x8 bfr = *(const bf16x8*)(Qs + (itl * 16 + (lane & 15)) * LDQ + kk * 32 + (lane >> 4) * 8);
                    a4 = mfma16(af, bfr, a4);
                }
            }
            const int i = itl * 16 + (lane & 15), j0 = jt * 16 + 4 * (lane >> 4);
            u32x2 wv; wv.x = cvt_pk(i >= j0 ? a4[0] : 0.f, i >= j0 + 1 ? a4[1] : 0.f); wv.y = cvt_pk(i >= j0 + 2 ? a4[2] : 0.f, i >= j0 + 3 ? a4[3] : 0.f);
            *(u32x2*)(As + i * LDA + j0) = wv;
        }
        lds_barrier();
        {
            f32x16 O;
#pragma unroll
            for (int r = 0; r < 16; ++r) O[r] = 0.f;
#pragma unroll
            for (int ks = 0; ks < 4; ++ks) {
                const bf16x8 vfr = *(const bf16x8*)(Vt + (ct * 32 + l31) * LDT + ((ks * 16 + 8 * hh + 8 * (((ct * 32 + l31) >> 3) & 7)) & 63));
                const bf16x8 af = *(const bf16x8*)(As + (rt * 32 + l31) * LDA + ks * 16 + 8 * hh);
                O = mfma32(af, vfr, O);
            }
#pragma unroll
            for (int ks = 0; ks < 8; ++ks) {
                const bf16x8 af = *(const bf16x8*)(Qs + (rt * 32 + l31) * LDQ + ks * 16 + 8 * hh);
                const bf16x8 bfr = *(const bf16x8*)(St + (ct * 32 + l31) * LDQ + ks * 16 + 8 * hh);
                O = mfma32(af, bfr, O);
            }
#pragma unroll
            for (int r = 0; r < 16; ++r) { const int i = rt * 32 + (r & 3) + 8 * (r >> 2) + 4 * hh; Ob[i * LDO + ct * 32 + l31] = O[r]; }
        }
        lds_barrier();
        {
            float o[16];
#pragma unroll
            for (int e4 = 0; e4 < 4; ++e4) { const f32x4 v = *(const f32x4*)(Ob + gi * LDO + gdv0 + e4 * 4); o[e4 * 4] = v[0]; o[e4 * 4 + 1] = v[1]; o[e4 * 4 + 2] = v[2]; o[e4 * 4 + 3] = v[3]; }
            float sm = 0.f;
#pragma unroll
            for (int e = 0; e < 16; ++e) sm += o[e];
            sm += __shfl_xor(sm, 1); sm += __shfl_xor(sm, 2); sm += __shfl_xor(sm, 4);
            const float mu = sm * (1.0f / 128.0f);
            float q = 0.f;
#pragma unroll
            for (int e = 0; e < 16; ++e) { const float d = o[e] - mu; q += d * d; }
            q += __shfl_xor(q, 1); q += __shfl_xor(q, 2); q += __shfl_xor(q, 4);
            const float rstd = rsqrtf(q * (1.0f / 128.0f) + 1e-5f);
            float r8[16];
#pragma unroll
            for (int e = 0; e < 8; ++e) {
                const unsigned wg = e < 4 ? gc1[e & 3] : gc2[e & 3];
                const float ga0 = e < 2 ? gw0[(2 * e) & 3] : e < 4 ? gw1[(2 * e) & 3] : e < 6 ? gw2[(2 * e) & 3] : gw3[(2 * e) & 3];
                const float ga1 = e < 2 ? gw0[(2 * e + 1) & 3] : e < 4 ? gw1[(2 * e + 1) & 3] : e < 6 ? gw2[(2 * e + 1) & 3] : gw3[(2 * e + 1) & 3];
                r8[2 * e] = (o[2 * e] - mu) * rstd * ga0 * silu_f(bf_lo(wg));
                r8[2 * e + 1] = (o[2 * e + 1] - mu) * rstd * ga1 * silu_f(bf_hi(wg));
            }
            bf16_t* mp = MX + ((size_t)b * 2048 + (size_t)c * 64 + gi) * DM + 512 + h * 128 + gdv0;
            *(u32x4*)mp = pack8(r8); *(u32x4*)(mp + 8) = pack8(r8 + 8);
        }
    }
#undef OUT_LOAD
    lds_barrier();
}

constexpr int W_KS = 0, W_VT = 36864;
constexpr int LDK = 72, LDV = 264;

template <bool SAMPLE>
__device__ __forceinline__ void swa_item(const Params& p, unsigned char* lds, int b, int blk, int kvh) {
    bf16_t* Ksw = (bf16_t*)(lds + W_KS); bf16_t* Vtw = (bf16_t*)(lds + W_VT);
    const bf16_t* Z = (const bf16_t*)(p.ws + WS_Z);
    bf16_t* MX = (bf16_t*)(p.ws + WS_MIX);
    const int tid = opaque_tid(), w = tid >> 6, lane = tid & 63, l31 = lane & 31, hh = lane >> 5;
    constexpr int NKEYS = SAMPLE ? 160 : 256;
    constexpr int NT = SAMPLE ? 1 : 2;
    bf16x8 Qf[4];
#define SWA_LOADQ(q2v) do { \
        const int _i0 = SAMPLE ? 0 : ((w & 1) * 2 + (q2v)) * 32; \
        const size_t _qrow = SAMPLE ? (size_t)NPROMPT + (size_t)b * 8 + (l31 & 7) : (size_t)b * 2048 + blk * 128 + _i0 + l31; \
        const int _head = SAMPLE ? kvh * 4 + (l31 >> 3) : kvh * 4 + (w >> 1); \
        _Pragma("unroll") for (int ks = 0; ks < 4; ++ks) Qf[ks] = *(const bf16x8*)(Z + (SAMPLE ? zrow_s(C_QA, 8, 64, _head, b, l31 & 7) : zrow_p(C_QA, 8, 64, _head, b, (size_t)blk * 128 + _i0 + l31)) + ks * 16 + 8 * hh); } while (0)
    SWA_LOADQ(0);
    for (int idx = tid; idx < NKEYS * 8; idx += 512) {
        const int j = idx >> 3, d0 = (idx & 7) * 8;
        u32x4 kq = {0u, 0u, 0u, 0u}, vq = {0u, 0u, 0u, 0u};
        if (!SAMPLE) {
            const int tk = blk * 128 - 128 + j;
            if (tk >= 0) { const size_t zo = zrow_p(0, 2, 64, kvh, b, tk) + d0; kq = *(const u32x4*)(Z + (size_t)MROWS * C_KA + zo); vq = *(const u32x4*)(Z + (size_t)MROWS * C_VA + zo); }
        } else {
            if (j < 128) {
                const float* ckp = p.ck + (((size_t)b * 128 + j) * 2 + kvh) * 64 + d0; const float* cvp = p.cv + (((size_t)b * 128 + j) * 2 + kvh) * 64 + d0;
                const f32x4 a0 = *(const f32x4*)ckp, a1 = *(const f32x4*)(ckp + 4), b0 = *(const f32x4*)cvp, b1 = *(const f32x4*)(cvp + 4);
                kq.x = cvt_pk(a0[0], a0[1]); kq.y = cvt_pk(a0[2], a0[3]); kq.z = cvt_pk(a1[0], a1[1]); kq.w = cvt_pk(a1[2], a1[3]);
                vq.x = cvt_pk(b0[0], b0[1]); vq.y = cvt_pk(b0[2], b0[3]); vq.z = cvt_pk(b1[0], b1[1]); vq.w = cvt_pk(b1[2], b1[3]);
            } else if (j < 136) {
                const size_t zo = zrow_s(0, 2, 64, kvh, b, j - 128) + d0; kq = *(const u32x4*)(Z + (size_t)MROWS * C_KA + zo); vq = *(const u32x4*)(Z + (size_t)MROWS * C_VA + zo);
            }
        }
        *(u32x4*)(Ksw + j * LDK + d0) = kq;
        const int kk = j & 15, jp = (((j & ~15) | (((kk >> 2) & 1) << 3) | (((kk >> 3) & 1) << 2) | (kk & 3)) + d0) & 255;
#pragma unroll
        for (int e = 0; e < 4; ++e) { Vtw[(d0 + 2 * e) * LDV + jp] = (bf16_t)(vq[e] & 0xffffu); Vtw[(d0 + 2 * e + 1) * LDV + jp] = (bf16_t)(vq[e] >> 16); }
    }
    lds_barrier();
    if (!SAMPLE || w == 0) {
        const int g = w >> 1;
#pragma unroll 1
        for (int q2 = 0; q2 < NT; ++q2) {

            const int i0 = SAMPLE ? 0 : ((w & 1) * 2 + q2) * 32;
                        const int head = SAMPLE ? kvh * 4 + (l31 >> 3) : kvh * 4 + g;
            const int iq = SAMPLE ? (l31 & 7) : i0 + l31;
            const float sink = p.sinks[head];
            f32x16 S[5];
#pragma unroll
            for (int kt = 0; kt < 5; ++kt) {
#pragma unroll
                for (int r = 0; r < 16; ++r) S[kt][r] = 0.f;
#pragma unroll
                for (int ks = 0; ks < 4; ++ks) { const bf16x8 kf = *(const bf16x8*)(Ksw + (i0 + 32 * kt + l31) * LDK + ks * 16 + 8 * hh); S[kt] = mfma32(kf, Qf[ks], S[kt]); }
            }
            if (q2 + 1 < NT) SWA_LOADQ(q2 + 1);
            float m = sink;
#pragma unroll
            for (int kt = 0; kt < 5; ++kt)
#pragma unroll
                for (int r = 0; r < 16; ++r) {
                    const int j = i0 + 32 * kt + (r & 3) + 8 * (r >> 2) + 4 * hh;
                    const bool valid = (j >= iq) && (j <= iq + 128) && (SAMPLE || blk > 0 || j >= 128);
                    const float s = valid ? S[kt][r] * 0.125f : -1e30f;
                    S[kt][r] = s; m = fmaxf(m, s);
                }
            m = fmaxf(m, __shfl_xor(m, 32));
            float sum = 0.f;
#pragma unroll
            for (int kt = 0; kt < 5; ++kt)
#pragma unroll
                for (int r = 0; r < 16; ++r) { const float e = __expf(S[kt][r] - m); S[kt][r] = e; sum += e; }
            sum += __shfl_xor(sum, 32);
            const float inv = 1.0f / (sum + __expf(sink - m));
            bf16_t graw[2][16];
#pragma unroll
            for (int dt = 0; dt < 2; ++dt)
#pragma unroll
                for (int r = 0; r < 16; ++r) {
                    const int qc = (r & 3) + 8 * (r >> 2) + 4 * hh;
                    const size_t orow = SAMPLE ? (size_t)NPROMPT + (size_t)b * 8 + (qc & 7) : (size_t)b * 2048 + blk * 128 + i0 + qc;
                    graw[dt][r] = Z[(SAMPLE ? zrow_s(C_GA, 8, 64, kvh * 4, b, 0) : zrow_p(C_GA, 8, 64, kvh * 4 + g, b, (size_t)blk * 128 + i0)) + qc * 64 + dt * 32 + l31];
                }
            f32x16 O[2];
#pragma unroll
            for (int dt = 0; dt < 2; ++dt)
#pragma unroll
                for (int r = 0; r < 16; ++r) O[dt][r] = 0.f;
#pragma unroll
            for (int kt = 0; kt < 5; ++kt)
#pragma unroll
                for (int s2 = 0; s2 < 2; ++s2) {
                    u32x4 pw;
                    pw.x = cvt_pk(S[kt][8 * s2 + 0] * inv, S[kt][8 * s2 + 1] * inv); pw.y = cvt_pk(S[kt][8 * s2 + 2] * inv, S[kt][8 * s2 + 3] * inv);
                    pw.z = cvt_pk(S[kt][8 * s2 + 4] * inv, S[kt][8 * s2 + 5] * inv); pw.w = cvt_pk(S[kt][8 * s2 + 6] * inv, S[kt][8 * s2 + 7] * inv);
#pragma unroll
                    for (int dt = 0; dt < 2; ++dt) { const bf16x8 vfr = *(const bf16x8*)(Vtw + (dt * 32 + l31) * LDV + ((i0 + 32 * kt + 16 * s2 + 8 * hh + 8 * (((dt * 32 + l31) >> 3) & 7)) & 255)); O[dt] = mfma32(as_frag(pw), vfr, O[dt]); }
                }
#pragma unroll
            for (int dt = 0; dt < 2; ++dt)
#pragma unroll
                for (int r = 0; r < 16; ++r) {
                    const int qc = (r & 3) + 8 * (r >> 2) + 4 * hh;
                    const size_t orow = SAMPLE ? (size_t)NPROMPT + (size_t)b * 8 + (qc & 7) : (size_t)b * 2048 + blk * 128 + i0 + qc;
                    const int col = (SAMPLE ? kvh * 4 + (qc >> 3) : kvh * 4 + g) * 64 + dt * 32 + l31;
                    const float gv = __uint_as_float(((unsigned)graw[dt][r]) << 16);
                    MX[orow * DM + col] = (bf16_t)(cvt_pk(O[dt][r] * silu_f(gv), 0.f) & 0xffffu);
                }
        }
    }
    lds_barrier();
#undef SWA_LOADQ
}

__device__ __forceinline__ void p2a_mixers(const Params& p, unsigned char* lds) {
    const int G = gridDim.x, bx = blockIdx.x;
    const int NRET = 64;
    if (G > NRET) {
        if (bx < NRET) { ret_chain(p, lds, bx >> 2, bx & 3); return; }
    } else {
        for (int it = bx; it < NRET; it += G) ret_chain(p, lds, it >> 2, it & 3);
    }
    const int nb = G > NRET ? G - NRET : G, me = G > NRET ? bx - NRET : bx;
    for (int it = me; it < 512 + 512 + 256; it += nb) {
        if (it < 512) { swa_item<false>(p, lds, it >> 5, (it >> 1) & 15, it & 1); }
        else if (it < 1024) { const int s = it - 512; ret_item<true>(p, lds, s >> 2, s & 3); }
        else { const int s = it - 1024; swa_item<true>(p, lds, s >> 1, 0, s & 1); }
    }
}

__global__ void __launch_bounds__(512) hymba_fwd(Params p) {
    extern __shared__ __attribute__((aligned(16))) unsigned char lds[];
    cg::grid_group grid = cg::this_grid();
    unsigned* bar = (unsigned*)(p.ws + WS_BAR);
    if (blockIdx.x == 0 && threadIdx.x == 0) __hip_atomic_store(bar, 0u, __ATOMIC_RELAXED, __HIP_MEMORY_SCOPE_AGENT);
    p0_prologue(p, lds);
    grid.sync();
    p1a_modulate(p);
    fast_grid_barrier(bar, 1u);
    {
        pg8::Gemm g{(const pg8::bf16_t*)(p.ws + WS_H), (const pg8::bf16_t*)(p.ws + WS_WIN), MROWS, DIN, DM};
        pg8::StaticOrder S; S.init(MROWS, DIN, (int)gridDim.x, (int)blockIdx.x);
        EpiZ E{(bf16_t*)(p.ws + WS_Z), p.out};
        pg8::gemm_phase<EpiZ, pg8::StaticOrder>((PG8_LAS unsigned char*)lds, g, S, E);
    }
    fast_grid_barrier(bar, 2u);
    p2a_mixers(p, lds);
    fast_grid_barrier(bar, 3u);
    p2b_ret_out(p, lds);
    fast_grid_barrier(bar, 4u);
    {
        pg8::Gemm g{(const pg8::bf16_t*)(p.ws + WS_MIX), (const pg8::bf16_t*)(p.ws + WS_WOUT), MROWS, DM, DM};
        pg8::StaticOrder S; S.init(MROWS, DM, (int)gridDim.x, (int)blockIdx.x);
        EpiY E{(bf16_t*)(p.ws + WS_Y)};
        pg8::gemm_phase<EpiY, pg8::StaticOrder>((PG8_LAS unsigned char*)lds, g, S, E);
    }
    fast_grid_barrier(bar, 5u);
    p4_layernorm(p);
}

extern "C" void kernel_launch(void* const* d_in, const int* in_sizes, int n_in, void* d_out, int out_size, void* d_ws, size_t ws_size, hipStream_t stream) {
    static int grid_blocks = 0;
    if (!grid_blocks) {
        int dev = 0, cus = 0, per_cu = 0;
        hipGetDevice(&dev);
        hipDeviceGetAttribute(&cus, hipDeviceAttributeMultiprocessorCount, dev);
        hipFuncSetAttribute((const void*)hymba_fwd, hipFuncAttributeMaxDynamicSharedMemorySize, LDS_BYTES);
        hipOccupancyMaxActiveBlocksPerMultiprocessor(&per_cu, (const void*)hymba_fwd, 512, LDS_BYTES);
        if (per_cu < 1) { fprintf(stderr, "kernel_launch: occupancy query reports %d blocks per CU\n", per_cu); per_cu = 1; }
        grid_blocks = cus * per_cu;
        if (grid_blocks > 256) grid_blocks = 256;
    }
    Params p{};
    p.xp = (const float*)d_in[0]; p.xs = (const float*)d_in[1]; p.cp = (const float*)d_in[2]; p.cs = (const float*)d_in[3];
    p.ck = (const float*)d_in[4]; p.cv = (const float*)d_in[5]; p.st = (const float*)d_in[6];
    p.w_ada = (const float*)d_in[7]; p.b_ada = (const float*)d_in[8]; p.w_in = (const float*)d_in[9]; p.sinks = (const float*)d_in[10];
    p.gn_w = (const float*)d_in[11]; p.w_out = (const float*)d_in[12]; p.ln_w = (const float*)d_in[13]; p.ln_b = (const float*)d_in[14];
    p.out = (float*)d_out; p.ws = (unsigned char*)d_ws;
    void* args[] = {&p};
    hipError_t e = hipLaunchCooperativeKernel((const void*)hymba_fwd, dim3(grid_blocks), dim3(512), args, LDS_BYTES, stream);
    if (e != hipSuccess) fprintf(stderr, "cooperative launch failed: %s (grid %d)\n", hipGetErrorString(e), grid_blocks);
}
```

```cpp
#include <hip/hip_runtime.h>
#include <hip/hip_cooperative_groups.h>
#include <cstdio>
namespace cg = cooperative_groups;
__device__ __forceinline__ void lds_barrier() { asm volatile("s_waitcnt lgkmcnt(0)" ::: "memory"); __builtin_amdgcn_s_barrier(); asm volatile("" ::: "memory"); }
__device__ __forceinline__ void fast_grid_barrier(unsigned* bar, unsigned seam) {
    __syncthreads();
    if (threadIdx.x == 0) {
        __builtin_amdgcn_fence(__ATOMIC_RELEASE, "agent");
        __hip_atomic_fetch_add(bar, 1u, __ATOMIC_RELAXED, __HIP_MEMORY_SCOPE_AGENT);
        const unsigned target = seam * gridDim.x;
        while (__hip_atomic_load(bar, __ATOMIC_RELAXED, __HIP_MEMORY_SCOPE_AGENT) < target) __builtin_amdgcn_s_sleep(2);
        __builtin_amdgcn_fence(__ATOMIC_ACQUIRE, "agent");
    }
    __syncthreads();
}
__device__ __forceinline__ int opaque_tid() { int t = threadIdx.x; asm volatile("" : "+v"(t)); return t; }
namespace pg8 {
#define PG8_LAS __attribute__((address_space(3)))
typedef unsigned short bf16_t;
typedef short bf16x8 __attribute__((ext_vector_type(8)));
typedef float f32x4 __attribute__((ext_vector_type(4)));
typedef unsigned u32x4 __attribute__((ext_vector_type(4)));
constexpr int BM = 256, BK = 64, HALF = 128, HTB = HALF * BK * 2  , STAGE_BYTES = 8 * HTB, NXCD = 8, WGM = 8;

__host__ __device__ __forceinline__ int lds_byte(int r, int c) { const int st = (r >> 4) * 2 + (c >> 5), rr = r & 15, cc = c & 31, ob = rr * 64 + cc * 2; return st * 1024 + (ob ^ (((ob >> 9) & 1) << 5)); }
__host__ __device__ __forceinline__ void stage_rc(int b, int& R, int& C) { const int st = b / 1024, sb = b % 1024, swz = sb ^ (((sb >> 9) & 1) << 5); R = (st >> 1) * 16 + swz / 64; C = (st & 1) * 32 + (swz % 64) / 2; }
__host__ __device__ __forceinline__ int perm32(int rho) { const int n = rho >> 4, i = rho & 15; return 8 * (i >> 2) + 4 * n + (i & 3); }

struct Unit { int pm, pn; };
struct Gemm { const bf16_t* A; const bf16_t* Bt; int M, N, K; };

struct StaticOrder {
    int nM, nN, nwg, G, c;
    __host__ __device__ void init(int M, int N, int G_, int c_) { nM = M / BM; nN = N / BM; nwg = nM * nN; G = G_; c = c_; }
    __host__ __device__ bool next(int i, Unit& u) const {
        const long L = (long)i * G + c; if (L >= nwg) return false;
        int wgid = (int)L; { const int q = nwg / NXCD, r = nwg % NXCD, xcd = wgid % NXCD, off = wgid / NXCD; wgid = (xcd < r ? xcd * (q + 1) : r * (q + 1) + (xcd - r) * q) + off; }
        const int nig = WGM * nN, gid = wgid / nig, fm = gid * WGM, gsz = (nM - fm) < WGM ? (nM - fm) : WGM;
        u.pm = fm + ((wgid % nig) % gsz); u.pn = (wgid % nig) / gsz; return true;
    }
    __device__ __forceinline__ void a_ready(const Unit&) const {}
    __device__ __forceinline__ void done(const Unit&) const {}
};
__device__ __forceinline__ unsigned cvt_pk_bf16(float lo, float hi) { unsigned r; asm volatile("v_cvt_pk_bf16_f32 %0, %1, %2" : "=v"(r) : "v"(lo), "v"(hi)); return r; }
template <class Epi, class Sched>
__device__ __forceinline__ void gemm_phase(PG8_LAS unsigned char* lds, const Gemm g, const Sched& S, const Epi& E) {
    const int tid = opaque_tid(), wid = __builtin_amdgcn_readfirstlane(tid >> 6), lane = tid & 63, wr = wid >> 2, wc = wid & 3, fr = lane & 15, fq = lane >> 4;
    const int K = g.K, nt = K / BK;
    unsigned voffA[2], voffB[2];
#pragma unroll
    for (int i = 0; i < 2; ++i) { int R, C; stage_rc(tid * 16 + i * 8192, R, C); const int Rb = Epi::PERM ? ((R & ~31) + perm32(R & 31)) : R;
        voffA[i] = (unsigned)(R * K + C) * 2u; voffB[i] = (unsigned)(Rb * K + C) * 2u; }
    const size_t kstep = (size_t)(BK * 2);
    const size_t hstep = (size_t)HALF * K * 2;
    const size_t tstep = 2 * hstep;
    const unsigned ldsw = (unsigned)wid * 1024u;
    const int aoff = lds_byte(wr * 64 + fr, fq * 8), boff = lds_byte(wc * 32 + fr, fq * 8);
#define PG8_SA(b, h) (((b) * 2 + (h)) * HTB)
#define PG8_SB(b, h) ((4 + (b) * 2 + (h)) * HTB)
#define PG8_STAGE(bufoff, gbase, voff) do { _Pragma("unroll") for (int _i = 0; _i < 2; ++_i) \
        __builtin_amdgcn_global_load_lds((const unsigned*)((const char*)(gbase) + (voff)[_i]), (PG8_LAS unsigned*)(lds + (bufoff) + ldsw + _i * 8192), 16, 0, 0); } while (0)
#define PG8_LDA(dst, b, h) do { _Pragma("unroll") for (int m = 0; m < 4; ++m) _Pragma("unroll") for (int k = 0; k < 2; ++k) dst[m][k] = *(const PG8_LAS bf16x8*)(lds + PG8_SA(b, h) + aoff + m * 2048 + k * 1024); } while (0)
#define PG8_LDB(dst, b, h) do { _Pragma("unroll") for (int n = 0; n < 2; ++n) _Pragma("unroll") for (int k = 0; k < 2; ++k) dst[n][k] = *(const PG8_LAS bf16x8*)(lds + PG8_SB(b, h) + boff + n * 2048 + k * 1024); } while (0)
#define PG8_MMA(ai, bj, At, Bt) do { __builtin_amdgcn_s_setprio(1); _Pragma("unroll") for (int m = 0; m < 4; ++m) _Pragma("unroll") for (int n = 0; n < 2; ++n) _Pragma("unroll") for (int k = 0; k < 2; ++k) \
        acc[ai][bj][m][n] = __builtin_amdgcn_mfma_f32_16x16x32_bf16(Bt[n][k], At[m][k], acc[ai][bj][m][n], 0, 0, 0); __builtin_amdgcn_s_setprio(0); } while (0)
#define PG8_WAIT_V(n) asm volatile("s_waitcnt vmcnt(" #n ")" ::: "memory")
#define PG8_WAIT_L(n) asm volatile("s_waitcnt lgkmcnt(" #n ")" ::: "memory")
#define PG8_BAR __builtin_amdgcn_s_barrier()
#define PG8_SCHED __builtin_amdgcn_sched_barrier(0)
    Unit cur, nxt; int ui = 0;
    if (!S.next(0, cur)) return;
    f32x4 acc[2][2][4][2];
#pragma unroll
    for (int a = 0; a < 2; ++a)
#pragma unroll
        for (int b = 0; b < 2; ++b)
#pragma unroll
            for (int m = 0; m < 4; ++m)
#pragma unroll
                for (int n = 0; n < 2; ++n) acc[a][b][m][n] = (f32x4){0.f, 0.f, 0.f, 0.f};
    bf16x8 At[4][2], B0[2][2], B1[2][2];
    const char* cA = (const char*)g.A + (size_t)cur.pm * tstep; const char* cB = (const char*)g.Bt + (size_t)cur.pn * tstep;
    S.a_ready(cur);
    PG8_STAGE(PG8_SB(0, 0), cB, voffB); PG8_STAGE(PG8_SA(0, 0), cA, voffA); PG8_STAGE(PG8_SB(0, 1), cB + hstep, voffB); PG8_STAGE(PG8_SA(0, 1), cA + hstep, voffA);
    if (wr == 1) PG8_BAR;
    PG8_WAIT_V(4); PG8_BAR;
    PG8_STAGE(PG8_SB(1, 0), cB + kstep, voffB); PG8_STAGE(PG8_SA(1, 0), cA + kstep, voffA); PG8_STAGE(PG8_SB(1, 1), cB + hstep + kstep, voffB);
    PG8_WAIT_V(6); PG8_BAR;
    for (;;) {
        const bool has_next = S.next(ui + 1, nxt);
        const char* nA = has_next ? (const char*)g.A + (size_t)nxt.pm * tstep : cA; const char* nB = has_next ? (const char*)g.Bt + (size_t)nxt.pn * tstep : cB;
        for (int t = 0; t < nt; t += 2) {
            const bool last = (t == nt - 2);
            const char* a1 = cA + (size_t)(t + 1) * kstep;
            const char* a2 = last ? nA : cA + (size_t)(t + 2) * kstep; const char* b2 = last ? nB : cB + (size_t)(t + 2) * kstep;
            const char* a3 = a2 + kstep; const char* b3 = b2 + kstep;
            if (last && has_next) S.a_ready(nxt);
            PG8_LDB(B0, 0, 0); PG8_SCHED; PG8_LDA(At, 0, 0); PG8_STAGE(PG8_SA(1, 1), a1 + hstep, voffA);
            PG8_WAIT_L(8); PG8_BAR; PG8_WAIT_L(0); PG8_MMA(0, 0, At, B0); PG8_BAR; PG8_SCHED;
            PG8_LDB(B1, 0, 1); PG8_STAGE(PG8_SB(0, 0), b2, voffB);
            PG8_BAR; PG8_WAIT_L(0); PG8_MMA(0, 1, At, B1); PG8_BAR;
            PG8_LDA(At, 0, 1); PG8_STAGE(PG8_SA(0, 0), a2, voffA);
            PG8_BAR; PG8_WAIT_L(0); PG8_MMA(1, 0, At, B0); PG8_BAR; PG8_SCHED;
            PG8_STAGE(PG8_SB(0, 1), b2 + hstep, voffB);
            PG8_WAIT_V(6); PG8_BAR; PG8_MMA(1, 1, At, B1); PG8_BAR;
            PG8_LDB(B0, 1, 0); PG8_SCHED; PG8_LDA(At, 1, 0); PG8_STAGE(PG8_SA(0, 1), a2 + hstep, voffA);
            PG8_WAIT_L(8); PG8_BAR; PG8_WAIT_L(0); PG8_MMA(0, 0, At, B0); PG8_BAR; PG8_SCHED;
            PG8_LDB(B1, 1, 1); PG8_STAGE(PG8_SB(1, 0), b3, voffB);
            PG8_BAR; PG8_WAIT_L(0); PG8_MMA(0, 1, At, B1); PG8_BAR;
            PG8_LDA(At, 1, 1); PG8_STAGE(PG8_SA(1, 0), a3, voffA);
            PG8_BAR; PG8_WAIT_L(0); PG8_MMA(1, 0, At, B0); PG8_BAR; PG8_SCHED;
            PG8_STAGE(PG8_SB(1, 1), b3 + hstep, voffB);
            PG8_WAIT_V(6); PG8_BAR; PG8_MMA(1, 1, At, B1); PG8_BAR;
        }
        if constexpr (!Epi::AFTER_DRAIN) { E(acc, cur, wr, wc, fr, fq); S.done(cur); }
        if (!has_next) break;
#pragma unroll
        for (int a = 0; a < 2; ++a)
#pragma unroll
            for (int b = 0; b < 2; ++b)
#pragma unroll
                for (int m = 0; m < 4; ++m)
#pragma unroll
                    for (int n = 0; n < 2; ++n) acc[a][b][m][n] = (f32x4){0.f, 0.f, 0.f, 0.f};
        cur = nxt; cA = nA; cB = nB; ++ui;
    }
    PG8_WAIT_V(0);
    if (wr == 0) PG8_BAR;
    PG8_BAR;
    if constexpr (Epi::AFTER_DRAIN) { E.fused(acc, cur, wr, wc, fr, fq, lds, wid, lane); S.done(cur); }
#undef PG8_SA
#undef PG8_SB
#undef PG8_STAGE
#undef PG8_LDA
#undef PG8_LDB
#undef PG8_MMA
#undef PG8_WAIT_V
#undef PG8_WAIT_L
#undef PG8_BAR
#undef PG8_SCHED
}
}

typedef unsigned short bf16_t;
typedef short bf16x8 __attribute__((ext_vector_type(8)));
typedef float f32x4 __attribute__((ext_vector_type(4)));
typedef float f32x16 __attribute__((ext_vector_type(16)));
typedef unsigned u32x4 __attribute__((ext_vector_type(4)));
typedef unsigned u32x2 __attribute__((ext_vector_type(2)));

constexpr int DM = 1024, NPROMPT = 32768, NSAMPLE = 1024, MROWS = NPROMPT + NSAMPLE, DIN = 3328;
constexpr int C_QA = 0, C_KA = 512, C_VA = 640, C_GA = 768, C_QR = 1280, C_KR = 1792, C_VR = 2304, C_GR = 2816;
constexpr float ALPHA = 1.189207115002721f;
constexpr size_t O_Y = 0, O_KWP = 34603008, O_VWP = 34865152, O_SP = 35127296, O_KWS = 36175872, O_VWS = 38273024, O_SS = 40370176;
constexpr size_t MiB = 1u << 20;
constexpr size_t WS_WIN = 0, WS_WOUT = 8 * MiB, WS_COND = 12 * MiB, WS_COS = 16 * MiB, WS_SIN = 17 * MiB, WS_STATS = 20 * MiB, WS_BAR = 24 * MiB,
                 WS_H = 32 * MiB, WS_Y = 32 * MiB, WS_MIX = 100 * MiB, WS_Z = 168 * MiB;
constexpr int LDS_BYTES = 155648;

__device__ __forceinline__ size_t zrow(int C, int nh, int hd, int h, size_t row) {
    const size_t tb = (size_t)MROWS * C;
    if (row < (size_t)NPROMPT) { const size_t b = row >> 11, t = row & 2047; return tb + ((b * nh + h) * 2048 + t) * hd; }
    const size_t sr = row - NPROMPT, sb = sr >> 3, st = sr & 7;
    return tb + (size_t)NPROMPT * nh * hd + ((sb * nh + h) * 8 + st) * hd;
}
__device__ __forceinline__ size_t zrow_p(int C, int nh, int hd, int h, size_t b, size_t t) { return (size_t)MROWS * C + ((b * nh + h) * 2048 + t) * hd; }
__device__ __forceinline__ size_t zrow_s(int C, int nh, int hd, int h, size_t sb, size_t st) { return (size_t)MROWS * C + (size_t)NPROMPT * nh * hd + ((sb * nh + h) * 8 + st) * hd; }
struct Params {
    const float* xp; const float* xs; const float* cp; const float* cs; const float* ck; const float* cv; const float* st;
    const float* w_ada; const float* b_ada; const float* w_in; const float* sinks; const float* gn_w; const float* w_out; const float* ln_w; const float* ln_b;
    float* out; unsigned char* ws;
};

__device__ __forceinline__ unsigned cvt_pk(float lo, float hi) { return pg8::cvt_pk_bf16(lo, hi); }
__device__ __forceinline__ float bf_lo(unsigned w) { return __uint_as_float(w << 16); }
__device__ __forceinline__ float bf_hi(unsigned w) { return __uint_as_float(w & 0xffff0000u); }
__device__ __forceinline__ float silu_f(float v) { return v * __builtin_amdgcn_rcpf(1.0f + __expf(-v)); }
__device__ __forceinline__ f32x16 mfma32(bf16x8 a, bf16x8 b, f32x16 c) { return __builtin_amdgcn_mfma_f32_32x32x16_bf16(a, b, c, 0, 0, 0); }
__device__ __forceinline__ f32x4 mfma16(bf16x8 a, bf16x8 b, f32x4 c) { return __builtin_amdgcn_mfma_f32_16x16x32_bf16(a, b, c, 0, 0, 0); }
__device__ __forceinline__ bf16x8 as_frag(u32x4 v) { return __builtin_bit_cast(bf16x8, v); }
__device__ __forceinline__ u32x4 pack8(const float* v) { u32x4 r; r.x = cvt_pk(v[0], v[1]); r.y = cvt_pk(v[2], v[3]); r.z = cvt_pk(v[4], v[5]); r.w = cvt_pk(v[6], v[7]); return r; }

struct EpiZ {
    static constexpr bool PERM = true, AFTER_DRAIN = false;
    bf16_t* Z; float* out;
    __device__ __forceinline__ void operator()(const f32x4 (&acc)[2][2][4][2], const pg8::Unit& u, int wr, int wc, int fr, int fq) const {
        const int row0 = u.pm * 256 + wr * 64 + fr;
        const bool smp = u.pm >= 128;
        bf16_t* P[2]; size_t step[2];
#pragma unroll
        for (int bj = 0; bj < 2; ++bj) {
            const int k128 = u.pn * 2 + bj;
            int C128, nh, hd;
            if (k128 < 4) { C128 = 0; nh = 8; hd = 64; } else if (k128 < 5) { C128 = 4; nh = 2; hd = 64; } else if (k128 < 6) { C128 = 5; nh = 2; hd = 64; }
            else if (k128 < 10) { C128 = 6; nh = 8; hd = 64; } else { C128 = 10 + (((k128 - 10) >> 2) << 2); nh = 4; hd = 128; }
            int h, d;
            if (hd == 128) { h = k128 - C128; d = wc * 32 + 8 * fq; } else { h = (k128 - C128) * 2 + (wc >> 1); d = (wc & 1) * 32 + 8 * fq; }
            const size_t tb = (size_t)MROWS * (size_t)(C128 * 128);
            if (!smp) { const int b = u.pm >> 3, t0 = (u.pm & 7) * 256 + wr * 64 + fr; P[bj] = Z + tb + ((size_t)(b * nh + h) * 2048 + t0) * hd + d; step[bj] = (size_t)16 * hd; }
            else { const int sr0 = (u.pm - 128) * 256 + wr * 64 + fr; P[bj] = Z + tb + (size_t)NPROMPT * nh * hd + ((size_t)((sr0 >> 3) * nh + h) * 8 + (sr0 & 7)) * hd + d; step[bj] = (size_t)16 * nh * hd; }
        }
#pragma unroll
        for (int ai = 0; ai < 2; ++ai)
#pragma unroll
            for (int m = 0; m < 4; ++m) {
                const int row = row0 + ai * 128 + m * 16;
#pragma unroll
                for (int bj = 0; bj < 2; ++bj) {
                    const f32x4 v0 = acc[ai][bj][m][0], v1 = acc[ai][bj][m][1];
                    u32x4 w; w.x = cvt_pk(v0[0], v0[1]); w.y = cvt_pk(v0[2], v0[3]); w.z = cvt_pk(v1[0], v1[1]); w.w = cvt_pk(v1[2], v1[3]);
                    *(u32x4*)(P[bj] + (size_t)(ai * 8 + m) * step[bj]) = w;
                }
                if (u.pn == 2) {
                    long base = -1;
                    size_t vofs = 0;
                    if (row < NPROMPT) { const int b = row >> 11, t = row & 2047; if (t >= 1920) { base = (long)O_KWP + (long)b * 16384 + (long)(t - 1920) * 128; vofs = O_VWP - O_KWP; } }
                    else { const int sr = row - NPROMPT, b = sr >> 3, t = sr & 7; base = (long)O_KWS + (long)b * 16384 + (long)(120 + t) * 128; vofs = O_VWS - O_KWS; }
                    if (base >= 0) {
                        const int cl = wc * 32 + 8 * fq;
#pragma unroll
                        for (int bj = 0; bj < 2; ++bj) {
                            float* dst = out + base + (bj ? vofs : 0) + cl;
                            *(f32x4*)dst = acc[ai][bj][m][0]; *(f32x4*)(dst + 4) = acc[ai][bj][m][1];
                        }
                    }
                }
            }
    }
};
struct EpiY {
    static constexpr bool PERM = true, AFTER_DRAIN = false;
    bf16_t* Y;
    __device__ __forceinline__ void operator()(const f32x4 (&acc)[2][2][4][2], const pg8::Unit& u, int wr, int wc, int fr, int fq) const {
        const int row0 = u.pm * 256 + wr * 64 + fr, col0 = u.pn * 256 + wc * 32 + 8 * fq;
#pragma unroll
        for (int ai = 0; ai < 2; ++ai)
#pragma unroll
            for (int m = 0; m < 4; ++m) {
                bf16_t* rowp = Y + (size_t)(row0 + ai * 128 + m * 16) * DM + col0;
#pragma unroll
                for (int bj = 0; bj < 2; ++bj) {
                    const f32x4 v0 = acc[ai][bj][m][0], v1 = acc[ai][bj][m][1];
                    u32x4 w; w.x = cvt_pk(v0[0], v0[1]); w.y = cvt_pk(v0[2], v0[3]); w.z = cvt_pk(v1[0], v1[1]); w.w = cvt_pk(v1[2], v1[3]);
                    *(u32x4*)(rowp + bj * 128) = w;
                }
            }
    }
};

__device__ __forceinline__ void p0_cond(const Params& p, unsigned char* lds, int nblk) {
    bf16_t* Bs = (bf16_t*)lds;
    const int tid = opaque_tid(), w = tid >> 6, lane = tid & 63, n0 = nblk * 16;
    float* cond = (float*)(p.ws + WS_COND);
    {
        float wv[32];
#pragma unroll
        for (int it = 0; it < 32; ++it) { const int idx = tid + it * 512; wv[it] = p.w_ada[(size_t)(idx >> 4) * 3072 + n0 + (idx & 15)]; }
#pragma unroll
        for (int it = 0; it < 32; ++it) { const int idx = tid + it * 512; Bs[(idx & 15) * 1032 + (idx >> 4)] = (bf16_t)(cvt_pk(wv[it], 0.f) & 0xffffu); }
    }
    __syncthreads();
    {
        f32x4 acc[9];
#pragma unroll
        for (int rt = 0; rt < 9; ++rt) acc[rt] = (f32x4){0.f, 0.f, 0.f, 0.f};
#pragma unroll
        for (int ks = 0; ks < 4; ++ks) {
            const int k0 = w * 128 + ks * 32 + (lane >> 4) * 8;
            const bf16x8 bfr = *(const bf16x8*)(Bs + (lane & 15) * 1032 + k0);
#pragma unroll
            for (int rt = 0; rt < 9; ++rt) {
                const float* crow = rt == 0 ? p.cp + (size_t)(lane & 15) * DM : p.cs + (size_t)((rt - 1) * 16 + (lane & 15)) * DM;
                const f32x4 a0 = *(const f32x4*)(crow + k0), a1 = *(const f32x4*)(crow + k0 + 4);
                u32x4 av; av.x = cvt_pk(silu_f(a0[0]), silu_f(a0[1])); av.y = cvt_pk(silu_f(a0[2]), silu_f(a0[3])); av.z = cvt_pk(silu_f(a1[0]), silu_f(a1[1])); av.w = cvt_pk(silu_f(a1[2]), silu_f(a1[3]));
                acc[rt] = mfma16(as_frag(av), bfr, acc[rt]);
            }
        }
        f32x4* part = (f32x4*)(lds + 40960);
#pragma unroll
        for (int rt = 0; rt < 9; ++rt) part[(w * 9 + rt) * 64 + lane] = acc[rt];
        __syncthreads();
        for (int t = tid; t < 576; t += 512) {
            const int rt = t >> 6, l = t & 63;
            f32x4 sum = {0.f, 0.f, 0.f, 0.f};
#pragma unroll
            for (int w2 = 0; w2 < 8; ++w2) sum += part[(w2 * 9 + rt) * 64 + l];
            const int n = n0 + (l & 15);
            const float bias = p.b_ada[n];
#pragma unroll
            for (int j = 0; j < 4; ++j) { const int r = rt * 16 + (l >> 4) * 4 + j; cond[(size_t)r * 3072 + n] = sum[j] + bias; }
        }
    }
    __syncthreads();
}
__device__ __forceinline__ void p0_tile_src(const Params& p, int t, const float*& W, bf16_t*& Wt, int& N, int& kt, int& nt) {
    if (t < 832) { W = p.w_in; Wt = (bf16_t*)(p.ws + WS_WIN); N = DIN; } else { W = p.w_out; Wt = (bf16_t*)(p.ws + WS_WOUT); N = 1024; t -= 832; }
    const int tiles_n = N / 64; kt = t / tiles_n; nt = t % tiles_n;
}
__device__ __forceinline__ void p0_transposes(const Params& p, unsigned char* lds, int t0, int nt_mine, int tstep) {
    float* T = (float*)lds;
    const int tid = opaque_tid();
    float v[8];
    if (nt_mine > 0) {
        const float* W; bf16_t* Wt; int N, kt, nt; p0_tile_src(p, t0, W, Wt, N, kt, nt);
#pragma unroll
        for (int e = 0; e < 8; ++e) { const int idx = tid + e * 512, k = idx >> 6, n = idx & 63; v[e] = W[(size_t)(kt * 64 + k) * N + nt * 64 + n]; }
    }
    for (int i = 0; i < nt_mine; ++i) {
        const int t = t0 + i * tstep;
        const float* W; bf16_t* Wt; int N, kt, nt; p0_tile_src(p, t, W, Wt, N, kt, nt);
#pragma unroll
        for (int e = 0; e < 8; ++e) { const int idx = tid + e * 512, k = idx >> 6, n = idx & 63; T[k * 65 + n] = v[e]; }
        lds_barrier();
        if (i + 1 < nt_mine) {
            const float* W2; bf16_t* Wt2; int N2, kt2, nt2; p0_tile_src(p, t + tstep, W2, Wt2, N2, kt2, nt2);
#pragma unroll
            for (int e = 0; e < 8; ++e) { const int idx = tid + e * 512, k = idx >> 6, n = idx & 63; v[e] = W2[(size_t)(kt2 * 64 + k) * N2 + nt2 * 64 + n]; }
        }
#pragma unroll
        for (int e = 0; e < 4; ++e) { const int idx = tid + e * 512, n = idx >> 5, k = (idx & 31) * 2;
            *(unsigned*)(Wt + (size_t)(nt * 64 + n) * 1024 + kt * 64 + k) = cvt_pk(T[k * 65 + n], T[(k + 1) * 65 + n]); }
        lds_barrier();
    }
}
__device__ __forceinline__ void p0_prologue(const Params& p, unsigned char* lds) {
    const int tid = threadIdx.x, G = gridDim.x, bx = blockIdx.x;
    if (G == 256) {
        if (bx < 192) { p0_cond(p, lds, bx); p0_transposes(p, lds, bx, 4, 192); }
        else p0_transposes(p, lds, 768 + (bx - 192), 5, 64);
    } else {
        for (int nb = bx; nb < 192; nb += G) p0_cond(p, lds, nb);
        int cnt = 0; for (int t = bx; t < 1088; t += G) ++cnt;
        p0_transposes(p, lds, bx, cnt, G);
    }
    float* tc = (float*)(p.ws + WS_COS); float* tsn = (float*)(p.ws + WS_SIN);
    for (int idx = bx * 512 + tid; idx < 2056 * 64; idx += G * 512) {
        const int r = idx >> 6, d = idx & 63;
        const float pos = (float)(r < 2048 ? r : 16384 + (r - 2048));
        const float inv = powf(10000.0f, -(float)d / 64.0f);
        const float ang = pos * inv;
        const double a = (double)ang;
        const double nrev = rint(a * 0.15915494309189535);
        const float red = (float)(a - nrev * 6.283185307179586);
        tc[idx] = __cosf(red); tsn[idx] = __sinf(red);
    }
    {
        const int NV = 128 * 3840, stride = G * 512;
        for (int base = bx * 512 + tid; base < NV; base += 4 * stride) {
            f32x4 kv[4], vv[4];
#pragma unroll
            for (int u = 0; u < 4; ++u) { const int idx = base + u * stride; if (idx < NV) { const int b = idx / 3840, e = (idx % 3840) * 4;
                kv[u] = __builtin_nontemporal_load((const f32x4*)(p.ck + (size_t)b * 16384 + 1024 + e)); vv[u] = __builtin_nontemporal_load((const f32x4*)(p.cv + (size_t)b * 16384 + 1024 + e)); } }
#pragma unroll
            for (int u = 0; u < 4; ++u) { const int idx = base + u * stride; if (idx < NV) { const int b = idx / 3840, e = (idx % 3840) * 4;
                *(f32x4*)(p.out + O_KWS + (size_t)b * 16384 + e) = kv[u]; *(f32x4*)(p.out + O_VWS + (size_t)b * 16384 + e) = vv[u]; } }
        }
    }
}
__device__ __forceinline__ void p1a_modulate(const Params& p) {
    const float* cond = (const float*)(p.ws + WS_COND);
    bf16_t* H = (bf16_t*)(p.ws + WS_H);
    const size_t NIT = (size_t)MROWS * 128, stride = (size_t)gridDim.x * 512;
    for (size_t base = (size_t)blockIdx.x * 512 + threadIdx.x; base < NIT; base += 4 * stride) {
        f32x4 x0[4], x1[4], sh0[4], sh1[4], sc0[4], sc1[4];
#pragma unroll
        for (int u = 0; u < 4; ++u) {
            const size_t it = base + u * stride;
            if (it < NIT) {
                const int row = (int)(it >> 7), c8 = (int)(it & 127) * 8;
                const float* xr = row < NPROMPT ? p.xp + (size_t)row * DM : p.xs + (size_t)(row - NPROMPT) * DM;
                const int crow = row < NPROMPT ? (row >> 11) : 16 + ((row - NPROMPT) >> 3);
                const float* cr = cond + (size_t)crow * 3072;
                x0[u] = __builtin_nontemporal_load((const f32x4*)(xr + c8)); x1[u] = __builtin_nontemporal_load((const f32x4*)(xr + c8 + 4));
                sh0[u] = *(const f32x4*)(cr + c8); sh1[u] = *(const f32x4*)(cr + c8 + 4);
                sc0[u] = *(const f32x4*)(cr + 1024 + c8); sc1[u] = *(const f32x4*)(cr + 1024 + c8 + 4);
            }
        }
#pragma unroll
        for (int u = 0; u < 4; ++u) {
            const size_t it = base + u * stride;
            if (it < NIT) {
                const int row = (int)(it >> 7), c8 = (int)(it & 127) * 8;
                const f32x4 h0 = x0[u] * (sc0[u] + 1.0f) + sh0[u], h1 = x1[u] * (sc1[u] + 1.0f) + sh1[u];
                u32x4 w; w.x = cvt_pk(h0[0], h0[1]); w.y = cvt_pk(h0[2], h0[3]); w.z = cvt_pk(h1[0], h1[1]); w.w = cvt_pk(h1[2], h1[3]);
                *(u32x4*)(H + (size_t)row * DM + c8) = w;
            }
        }
    }
}
__device__ __forceinline__ void p4_layernorm(const Params& p) {
    const float* cond = (const float*)(p.ws + WS_COND);
    const bf16_t* Y = (const bf16_t*)(p.ws + WS_Y);
    const int w = threadIdx.x >> 6, lane = threadIdx.x & 63;
    for (int row0 = (blockIdx.x * 8 + w) * 2; row0 < MROWS; row0 += gridDim.x * 16) {
        f32x4 r[2][4];
#pragma unroll
        for (int rr = 0; rr < 2; ++rr) {
            const int row = row0 + rr;
            const float* xr = row < NPROMPT ? p.xp + (size_t)row * DM : p.xs + (size_t)(row - NPROMPT) * DM;
            const int crow = row < NPROMPT ? (row >> 11) : 16 + ((row - NPROMPT) >> 3);
            const float* gr = cond + (size_t)crow * 3072 + 2048;
            const bf16_t* yr = Y + (size_t)row * DM;
#pragma unroll
            for (int i = 0; i < 4; ++i) {
                const int c = (i * 64 + lane) * 4;
                const f32x4 xv = *(const f32x4*)(xr + c), gv = *(const f32x4*)(gr + c);
                const u32x2 yw = *(const u32x2*)(yr + c);
                f32x4 yv; yv[0] = bf_lo(yw.x); yv[1] = bf_hi(yw.x); yv[2] = bf_lo(yw.y); yv[3] = bf_hi(yw.y);
                r[rr][i] = xv * ALPHA + gv * yv;
            }
        }
#pragma unroll
        for (int rr = 0; rr < 2; ++rr) {
            float s = 0.f;
#pragma unroll
            for (int i = 0; i < 4; ++i) s += (r[rr][i][0] + r[rr][i][1]) + (r[rr][i][2] + r[rr][i][3]);
#pragma unroll
            for (int o = 1; o < 64; o <<= 1) s += __shfl_xor(s, o);
            const float mu = s * (1.0f / 1024.0f);
            float q = 0.f;
#pragma unroll
            for (int i = 0; i < 4; ++i) { const f32x4 d = r[rr][i] - mu; q += (d[0] * d[0] + d[1] * d[1]) + (d[2] * d[2] + d[3] * d[3]); }
#pragma unroll
            for (int o = 1; o < 64; o <<= 1) q += __shfl_xor(q, o);
            const float rstd = rsqrtf(q * (1.0f / 1024.0f) + 1e-5f);
            float* o = p.out + (size_t)(row0 + rr) * DM;
#pragma unroll
            for (int i = 0; i < 4; ++i) {
                const int c = (i * 64 + lane) * 4;
                const f32x4 lw = *(const f32x4*)(p.ln_w + c), lb = *(const f32x4*)(p.ln_b + c);
                *(f32x4*)(o + c) = (r[rr][i] - mu) * rstd * lw + lb;
            }
        }
    }
}

constexpr int R_QS = 0, R_KS = 17408, R_KT = 34816, R_VT = 55296, R_AS = 75776, R_ST = 84992, R_OB = 119808;
constexpr int LDQ = 136, LDT = 80, LDA = 72, LDO = 132;

__device__ __forceinline__ void ret_write_st(bf16_t* St, const f32x16 (&Sacc)[2], int kt0, int ct, int l31, int hh) {
#pragma unroll
    for (int t2 = 0; t2 < 2; ++t2)
#pragma unroll
        for (int g4 = 0; g4 < 4; ++g4) {
            const int dk0 = (kt0 + t2) * 32 + 8 * g4 + 4 * hh, dv = ct * 32 + l31;
            u32x2 w; w.x = cvt_pk(Sacc[t2][4 * g4 + 0], Sacc[t2][4 * g4 + 1]); w.y = cvt_pk(Sacc[t2][4 * g4 + 2], Sacc[t2][4 * g4 + 3]);
            *(u32x2*)(St + dv * LDQ + dk0) = w;
        }
}

template <bool SAMPLE>
__device__ __forceinline__ void ret_item(const Params& p, unsigned char* lds, int b, int h) {
    bf16_t* Qs = (bf16_t*)(lds + R_QS); bf16_t* Ks = (bf16_t*)(lds + R_KS); bf16_t* Kt = (bf16_t*)(lds + R_KT); bf16_t* Vt = (bf16_t*)(lds + R_VT);
    bf16_t* As = (bf16_t*)(lds + R_AS); bf16_t* St = (bf16_t*)(lds + R_ST); float* Ob = (float*)(lds + R_OB);
    const bf16_t* Z = (const bf16_t*)(p.ws + WS_Z);
    bf16_t* MX = (bf16_t*)(p.ws + WS_MIX);
    const float* tcs = (const float*)(p.ws + WS_COS); const float* tsn = (const float*)(p.ws + WS_SIN);
    const int tid = opaque_tid(), w = tid >> 6, lane = tid & 63, l31 = lane & 31, hh = lane >> 5;
    const float lg = logf(1.0f - exp2f(-5.0f - (float)h));
    const int nchunk = SAMPLE ? 1 : 32;
    const float gL = expf(lg * (SAMPLE ? 8.0f : 64.0f));
    const size_t rowbase = SAMPLE ? (size_t)NPROMPT + (size_t)b * 8 : (size_t)b * 2048;
    const int ct = w & 3, kt0 = (w >> 2) * 2, rt = w >> 2;
    const int si = lane, sd0 = w * 8, sdv0 = w * 16;
    const bool svalid = !SAMPLE || si < 8;
    const float qd = expf(lg * (float)(si + 1)), kd = expf(-lg * (float)(si + 1)) * 0.08838834764831845f;
    const int gi = tid >> 3, gdv0 = (tid & 7) * 16;
    float gwv[16];
#pragma unroll
    for (int e = 0; e < 16; ++e) gwv[e] = p.gn_w[h * 128 + gdv0 + e];
    u32x4 q1, q2, k1, k2, v1, v2, gn1, gn2, gc1, gc2; f32x4 c0, c1, s0, s1;
#define RET_LOAD(cc) do { \
        const size_t _row = rowbase + (size_t)(cc) * 64 + (SAMPLE ? (si & 7) : si); \
        const int _trow = SAMPLE ? 2048 + (si & 7) : (cc) * 64 + si; \
        const size_t _zo = SAMPLE ? zrow_s(0, 4, 128, h, b, si & 7) : zrow_p(0, 4, 128, h, b, (size_t)(cc) * 64 + si); \
        const bf16_t* _zq = Z + (size_t)MROWS * C_QR + _zo; const bf16_t* _zk = Z + (size_t)MROWS * C_KR + _zo; const bf16_t* _zv = Z + (size_t)MROWS * C_VR + _zo; \
        q1 = *(const u32x4*)(_zq + sd0); q2 = *(const u32x4*)(_zq + 64 + sd0); \
        k1 = *(const u32x4*)(_zk + sd0); k2 = *(const u32x4*)(_zk + 64 + sd0); \
        v1 = *(const u32x4*)(_zv + sdv0); v2 = *(const u32x4*)(_zv + sdv0 + 8); \
        c0 = *(const f32x4*)(tcs + _trow * 64 + sd0); c1 = *(const f32x4*)(tcs + _trow * 64 + sd0 + 4); \
        s0 = *(const f32x4*)(tsn + _trow * 64 + sd0); s1 = *(const f32x4*)(tsn + _trow * 64 + sd0 + 4); \
        const size_t _grow = rowbase + (size_t)(cc) * 64 + (SAMPLE ? (gi & 7) : gi); \
        const bf16_t* _gp = Z + (SAMPLE ? zrow_s(C_GR, 4, 128, h, b, gi & 7) : zrow_p(C_GR, 4, 128, h, b, (size_t)(cc) * 64 + gi)) + gdv0; \
        gn1 = *(const u32x4*)_gp; gn2 = *(const u32x4*)(_gp + 8); } while (0)
    RET_LOAD(0);
    f32x16 Sacc[2];
    if (SAMPLE) {
        const float* sp = p.st + (size_t)(b * 4 + h) * 16384;
#pragma unroll
        for (int t2 = 0; t2 < 2; ++t2)
#pragma unroll
            for (int r = 0; r < 16; ++r) { const int dk = (kt0 + t2) * 32 + (r & 3) + 8 * (r >> 2) + 4 * hh; Sacc[t2][r] = sp[dk * 128 + ct * 32 + l31]; }
    } else {
#pragma unroll
        for (int t2 = 0; t2 < 2; ++t2)
#pragma unroll
            for (int r = 0; r < 16; ++r) Sacc[t2][r] = 0.f;
    }
    ret_write_st(St, Sacc, kt0, ct, l31, hh);
    for (int c = 0; c < nchunk; ++c) {
        {
            float qa[8], qb[8], ka[8], kb[8];
#pragma unroll
            for (int e = 0; e < 4; ++e) {
                const unsigned wq1 = q1[e], wq2 = q2[e], wk1 = k1[e], wk2 = k2[e];
#pragma unroll
                for (int hf = 0; hf < 2; ++hf) {
                    const int ee = e * 2 + hf;
                    const float cs = ee < 4 ? c0[ee & 3] : c1[ee & 3], sn = ee < 4 ? s0[ee & 3] : s1[ee & 3];
                    const float x1 = hf ? bf_hi(wq1) : bf_lo(wq1), x2 = hf ? bf_hi(wq2) : bf_lo(wq2);
                    const float y1 = hf ? bf_hi(wk1) : bf_lo(wk1), y2 = hf ? bf_hi(wk2) : bf_lo(wk2);
                    qa[ee] = svalid ? (x1 * cs - x2 * sn) * qd : 0.f; qb[ee] = svalid ? (x2 * cs + x1 * sn) * qd : 0.f;
                    ka[ee] = svalid ? (y1 * cs - y2 * sn) * kd : 0.f; kb[ee] = svalid ? (y2 * cs + y1 * sn) * kd : 0.f;
                }
            }
            const u32x4 pqa = pack8(qa), pqb = pack8(qb), pka = pack8(ka), pkb = pack8(kb);
            *(u32x4*)(Qs + si * LDQ + sd0) = pqa; *(u32x4*)(Qs + si * LDQ + 64 + sd0) = pqb;
            *(u32x4*)(Ks + si * LDQ + sd0) = pka; *(u32x4*)(Ks + si * LDQ + 64 + sd0) = pkb;
#pragma unroll
            for (int e = 0; e < 4; ++e) {
                Kt[(sd0 + 2 * e) * LDT + si] = (bf16_t)(pka[e] & 0xffffu); Kt[(sd0 + 2 * e + 1) * LDT + si] = (bf16_t)(pka[e] >> 16);
                Kt[(64 + sd0 + 2 * e) * LDT + si] = (bf16_t)(pkb[e] & 0xffffu); Kt[(64 + sd0 + 2 * e + 1) * LDT + si] = (bf16_t)(pkb[e] >> 16);
            }
            if (!svalid) { v1 = (u32x4){0u, 0u, 0u, 0u}; v2 = v1; }
#pragma unroll
            for (int e = 0; e < 4; ++e) {
                Vt[(sdv0 + 2 * e) * LDT + si] = (bf16_t)(v1[e] & 0xffffu); Vt[(sdv0 + 2 * e + 1) * LDT + si] = (bf16_t)(v1[e] >> 16);
                Vt[(sdv0 + 8 + 2 * e) * LDT + si] = (bf16_t)(v2[e] & 0xffffu); Vt[(sdv0 + 8 + 2 * e + 1) * LDT + si] = (bf16_t)(v2[e] >> 16);
            }
            gc1 = gn1; gc2 = gn2;
        }
        if (c + 1 < nchunk) RET_LOAD(c + 1);
        lds_barrier();
#pragma unroll
        for (int tq = 0; tq < 2; ++tq) {
            const int tt = w + tq * 8, jt = tt >> 2, it = tt & 3;
            f32x4 a4 = {0.f, 0.f, 0.f, 0.f};
            if (it >= jt) {
#pragma unroll
                for (int kk = 0; kk < 4; ++kk) {
                    const bf16x8 af = *(const bf16x8*)(Ks + (jt * 16 + (lane & 15)) * LDQ + kk * 32 + (lane >> 4) * 8);
                    const bf16x8 bfr = *(const bf16x8*)(Qs + (it * 16 + (lane & 15)) * LDQ + kk * 32 + (lane >> 4) * 8);
                    a4 = mfma16(af, bfr, a4);
                }
            }
            const int i = it * 16 + (lane & 15), j0 = jt * 16 + 4 * (lane >> 4);
            u32x2 wv; wv.x = cvt_pk(i >= j0 ? a4[0] : 0.f, i >= j0 + 1 ? a4[1] : 0.f); wv.y = cvt_pk(i >= j0 + 2 ? a4[2] : 0.f, i >= j0 + 3 ? a4[3] : 0.f);
            *(u32x2*)(As + i * LDA + j0) = wv;
        }
        lds_barrier();
        {
            f32x16 O;
#pragma unroll
            for (int r = 0; r < 16; ++r) O[r] = 0.f;
            bf16x8 vf[4];
#pragma unroll
            for (int ks = 0; ks < 4; ++ks) vf[ks] = *(const bf16x8*)(Vt + (ct * 32 + l31) * LDT + ks * 16 + 8 * hh);
#pragma unroll
            for (int ks = 0; ks < 4; ++ks) { const bf16x8 af = *(const bf16x8*)(As + (rt * 32 + l31) * LDA + ks * 16 + 8 * hh); O = mfma32(af, vf[ks], O); }
#pragma unroll
            for (int ks = 0; ks < 8; ++ks) {
                const bf16x8 af = *(const bf16x8*)(Qs + (rt * 32 + l31) * LDQ + ks * 16 + 8 * hh);
                const bf16x8 bfr = *(const bf16x8*)(St + (ct * 32 + l31) * LDQ + ks * 16 + 8 * hh);
                O = mfma32(af, bfr, O);
            }
#pragma unroll
            for (int t2 = 0; t2 < 2; ++t2) {
#pragma unroll
                for (int ks = 0; ks < 4; ++ks) { const bf16x8 af = *(const bf16x8*)(Kt + ((kt0 + t2) * 32 + l31) * LDT + ks * 16 + 8 * hh); Sacc[t2] = mfma32(af, vf[ks], Sacc[t2]); }
#pragma unroll
                for (int r = 0; r < 16; ++r) Sacc[t2][r] *= gL;
            }
#pragma unroll
            for (int r = 0; r < 16; ++r) { const int i = rt * 32 + (r & 3) + 8 * (r >> 2) + 4 * hh; Ob[i * LDO + ct * 32 + l31] = O[r]; }
        }
        lds_barrier();
        if (c + 1 < nchunk) ret_write_st(St, Sacc, kt0, ct, l31, hh);
        {
            float o[16];
#pragma unroll
            for (int e4 = 0; e4 < 4; ++e4) { const f32x4 v = *(const f32x4*)(Ob + gi * LDO + gdv0 + e4 * 4); o[e4 * 4] = v[0]; o[e4 * 4 + 1] = v[1]; o[e4 * 4 + 2] = v[2]; o[e4 * 4 + 3] = v[3]; }
            float s = 0.f;
#pragma unroll
            for (int e = 0; e < 16; ++e) s += o[e];
            s += __shfl_xor(s, 1); s += __shfl_xor(s, 2); s += __shfl_xor(s, 4);
            const float mu = s * (1.0f / 128.0f);
            float q = 0.f;
#pragma unroll
            for (int e = 0; e < 16; ++e) { const float d = o[e] - mu; q += d * d; }
            q += __shfl_xor(q, 1); q += __shfl_xor(q, 2); q += __shfl_xor(q, 4);
            const float rstd = rsqrtf(q * (1.0f / 128.0f) + 1e-5f);
            if (!SAMPLE || gi < 8) {
                const size_t row = rowbase + (size_t)c * 64 + gi;
                float r8[16];
#pragma unroll
                for (int e = 0; e < 8; ++e) {
                    const unsigned wg = e < 4 ? gc1[e & 3] : gc2[e & 3];
                    const float ga = bf_lo(wg), gb = bf_hi(wg);
                    r8[2 * e] = (o[2 * e] - mu) * rstd * gwv[2 * e] * silu_f(ga);
                    r8[2 * e + 1] = (o[2 * e + 1] - mu) * rstd * gwv[2 * e + 1] * silu_f(gb);
                }
                bf16_t* mp = MX + row * DM + 512 + h * 128 + gdv0;
                *(u32x4*)mp = pack8(r8); *(u32x4*)(mp + 8) = pack8(r8 + 8);
            }
        }
    }
#undef RET_LOAD
    float* dst = p.out + (SAMPLE ? O_SS : O_SP) + (size_t)(b * 4 + h) * 16384;
#pragma unroll
    for (int t2 = 0; t2 < 2; ++t2)
#pragma unroll
        for (int r = 0; r < 16; ++r) { const int dk = (kt0 + t2) * 32 + (r & 3) + 8 * (r >> 2) + 4 * hh; dst[dk * 128 + ct * 32 + l31] = Sacc[t2][r]; }
    lds_barrier();
}

constexpr size_t WS_SC = 400 * MiB;
__device__ __forceinline__ void ret_chain(const Params& p, unsigned char* lds, int b, int h) {
    const bf16_t* Z = (const bf16_t*)(p.ws + WS_Z);
    const float* tcs = (const float*)(p.ws + WS_COS); const float* tsn = (const float*)(p.ws + WS_SIN);
    const int tid = opaque_tid(), w = tid >> 6, lane = tid & 63, l31 = lane & 31, hh = lane >> 5;
    const float lg = __logf(1.0f - exp2f(-5.0f - (float)h));
    const float gL = expf(lg * 64.0f);
    const int ct = w & 3, kt0 = (w >> 2) * 2;
    const int si = tid >> 3, sd0 = (tid & 7) * 8, srot = (tid & 7) * 8;
    const int sc = (si + srot) & 63;
    const float kd = __expf(-lg * (float)(si + 1)) * 0.08838834764831845f;
    u32x2* SC = (u32x2*)(p.ws + WS_SC) + (size_t)(b * 4 + h) * 32 * 4096;
    f32x16 Sacc[2];
#pragma unroll
    for (int t2 = 0; t2 < 2; ++t2)
#pragma unroll
        for (int r = 0; r < 16; ++r) Sacc[t2][r] = 0.f;
    u32x4 k1A, k2A, v1A, v2A, k1B, k2B, v1B, v2B; f32x4 c0A, c1A, s0A, s1A, c0B, c1B, s0B, s1B;
#define CH_LOAD(cc, X) do { \
        const size_t _row = (size_t)b * 2048 + (size_t)(cc) * 64 + si; const int _trow = (cc) * 64 + si; \
        const size_t _zo = zrow_p(0, 4, 128, h, b, (size_t)(cc) * 64 + si); const bf16_t* _zk = Z + (size_t)MROWS * C_KR + _zo; const bf16_t* _zv = Z + (size_t)MROWS * C_VR + _zo; \
        k1##X = *(const u32x4*)(_zk + sd0); k2##X = *(const u32x4*)(_zk + 64 + sd0); \
        v1##X = *(const u32x4*)(_zv + sd0); v2##X = *(const u32x4*)(_zv + 64 + sd0); \
        c0##X = *(const f32x4*)(tcs + _trow * 64 + sd0); c1##X = *(const f32x4*)(tcs + _trow * 64 + sd0 + 4); \
        s0##X = *(const f32x4*)(tsn + _trow * 64 + sd0); s1##X = *(const f32x4*)(tsn + _trow * 64 + sd0 + 4); } while (0)
#define CH_LOAD_R(cc, X) do { \
        const size_t _zo = zrow_p(0, 4, 128, h, b, (size_t)(cc) * 64 + si); const bf16_t* _zk = Z + (size_t)MROWS * C_KR + _zo; const bf16_t* _zv = Z + (size_t)MROWS * C_VR + _zo; \
        k1##X = *(const u32x4*)(_zk + sd0); k2##X = *(const u32x4*)(_zk + 64 + sd0); \
        v1##X = *(const u32x4*)(_zv + sd0); v2##X = *(const u32x4*)(_zv + 64 + sd0); \
        { const f32x4 _c0 = c0##X * rc0 - s0##X * rs0, _s0 = s0##X * rc0 + c0##X * rs0, _c1 = c1##X * rc1 - s1##X * rs1, _s1 = s1##X * rc1 + c1##X * rs1; \
          c0##X = _c0; s0##X = _s0; c1##X = _c1; s1##X = _s1; } } while (0)
#define CH_STORE(bufi, X) do { \
        bf16_t* _Kt = (bf16_t*)(lds + (bufi) * 40960); bf16_t* _Vt = (bf16_t*)(lds + (bufi) * 40960 + 20480); \
        float ka[8], kb[8]; \
        _Pragma("unroll") for (int e = 0; e < 4; ++e) { const unsigned wk1 = k1##X[e], wk2 = k2##X[e]; \
            _Pragma("unroll") for (int hf = 0; hf < 2; ++hf) { const int ee = e * 2 + hf; \
                const float cs = ee < 4 ? c0##X[ee & 3] : c1##X[ee & 3], sn = ee < 4 ? s0##X[ee & 3] : s1##X[ee & 3]; \
                const float y1 = hf ? bf_hi(wk1) : bf_lo(wk1), y2 = hf ? bf_hi(wk2) : bf_lo(wk2); \
                ka[ee] = (y1 * cs - y2 * sn) * kd; kb[ee] = (y2 * cs + y1 * sn) * kd; } } \
        const u32x4 pka = pack8(ka), pkb = pack8(kb); \
        _Pragma("unroll") for (int e = 0; e < 4; ++e) { \
            _Kt[(sd0 + 2 * e) * LDT + sc] = (bf16_t)(pka[e] & 0xffffu); _Kt[(sd0 + 2 * e + 1) * LDT + sc] = (bf16_t)(pka[e] >> 16); \
            _Kt[(64 + sd0 + 2 * e) * LDT + sc] = (bf16_t)(pkb[e] & 0xffffu); _Kt[(64 + sd0 + 2 * e + 1) * LDT + sc] = (bf16_t)(pkb[e] >> 16); \
            _Vt[(sd0 + 2 * e) * LDT + sc] = (bf16_t)(v1##X[e] & 0xffffu); _Vt[(sd0 + 2 * e + 1) * LDT + sc] = (bf16_t)(v1##X[e] >> 16); \
            _Vt[(64 + sd0 + 2 * e) * LDT + sc] = (bf16_t)(v2##X[e] & 0xffffu); _Vt[(64 + sd0 + 2 * e + 1) * LDT + sc] = (bf16_t)(v2##X[e] >> 16); } } while (0)
#define CH_STEP(c, X) do { \
        lds_barrier(); \
        { u32x2* dst = SC + (size_t)(((c) + 31) & 31) * 4096 + (size_t)w * 512 + lane; \
          _Pragma("unroll") for (int t2 = 0; t2 < 2; ++t2) _Pragma("unroll") for (int g4 = 0; g4 < 4; ++g4) { \
              u32x2 wv; wv.x = cvt_pk(Sacc[t2][4 * g4 + 0], Sacc[t2][4 * g4 + 1]); wv.y = cvt_pk(Sacc[t2][4 * g4 + 2], Sacc[t2][4 * g4 + 3]); \
              dst[(t2 * 4 + g4) * 64] = wv; } } \
        CH_STORE(((c) + 1) & 1, X); \
        { const int cn = (c) + 3 < 32 ? (c) + 3 : 31; CH_LOAD_R(cn, X); } \
        asm volatile("" ::: "memory"); __builtin_amdgcn_sched_barrier(0); \
        { const bf16_t* Kt = (const bf16_t*)(lds + ((c) & 1) * 40960); const bf16_t* Vt = (const bf16_t*)(lds + ((c) & 1) * 40960 + 20480); \
          bf16x8 vf[4]; \
          _Pragma("unroll") for (int ks = 0; ks < 4; ++ks) vf[ks] = *(const bf16x8*)(Vt + (ct * 32 + l31) * LDT + ((ks * 16 + 8 * hh + 8 * (((ct * 32 + l31) >> 3) & 7)) & 63)); \
          _Pragma("unroll") for (int t2 = 0; t2 < 2; ++t2) { \
              _Pragma("unroll") for (int ks = 0; ks < 4; ++ks) { const bf16x8 af = *(const bf16x8*)(Kt + ((kt0 + t2) * 32 + l31) * LDT + ((ks * 16 + 8 * hh + 8 * ((((kt0 + t2) * 32 + l31) >> 3) & 7)) & 63)); Sacc[t2] = mfma32(af, vf[ks], Sacc[t2]); } \
              _Pragma("unroll") for (int r = 0; r < 16; ++r) Sacc[t2][r] *= gL; } } } while (0)
    const f32x4 rc0 = *(const f32x4*)(tcs + 128 * 64 + sd0), rc1 = *(const f32x4*)(tcs + 128 * 64 + sd0 + 4), rs0 = *(const f32x4*)(tsn + 128 * 64 + sd0), rs1 = *(const f32x4*)(tsn + 128 * 64 + sd0 + 4);
    CH_LOAD(0, A);
    CH_STORE(0, A);
    CH_LOAD(1, A);
    CH_LOAD(2, B);
    for (int c = 0; c < 32; c += 2) {
        CH_STEP(c, A);
        CH_STEP(c + 1, B);
    }
#undef CH_LOAD
#undef CH_LOAD_R
#undef CH_STORE
#undef CH_STEP
    float* dst = p.out + O_SP + (size_t)(b * 4 + h) * 16384;
#pragma unroll
    for (int t2 = 0; t2 < 2; ++t2)
#pragma unroll
        for (int r = 0; r < 16; ++r) { const int dk = (kt0 + t2) * 32 + (r & 3) + 8 * (r >> 2) + 4 * hh; dst[dk * 128 + ct * 32 + l31] = Sacc[t2][r]; }
    lds_barrier();
}

__device__ __forceinline__ void p2b_ret_out(const Params& p, unsigned char* lds) {
    bf16_t* Qs = (bf16_t*)(lds + R_QS); bf16_t* Ks = (bf16_t*)(lds + R_KS); bf16_t* Vt = (bf16_t*)(lds + R_VT);
    bf16_t* As = (bf16_t*)(lds + R_AS); bf16_t* St = (bf16_t*)(lds + R_ST); float* Ob = (float*)(lds + R_OB);
    const bf16_t* Z = (const bf16_t*)(p.ws + WS_Z);
    bf16_t* MX = (bf16_t*)(p.ws + WS_MIX);
    const float* tcs = (const float*)(p.ws + WS_COS); const float* tsn = (const float*)(p.ws + WS_SIN);
    const int tid = opaque_tid(), w = tid >> 6, lane = tid & 63, l31 = lane & 31, hh = lane >> 5;
    const int ct = w & 3, kt0 = (w >> 2) * 2, rt = w >> 2;
    const int si = tid >> 3, sd0 = (tid & 7) * 8, sc = (si + (tid & 7) * 8) & 63;
    const int gi = tid >> 3, gdv0 = (tid & 7) * 16;
    const int G = gridDim.x;
    u32x4 q1, q2, k1, k2, v1, v2, gn1, gn2; f32x4 c0, c1, s0, s1, gwn0, gwn1, gwn2, gwn3; u32x2 sfr[8];
#define OUT_LOAD(itv) do { \
        const int _b = (itv) >> 7, _h = ((itv) >> 5) & 3, _c = (itv) & 31; \
        const size_t _zo = zrow_p(0, 4, 128, _h, _b, (size_t)_c * 64 + si); const int _trow = _c * 64 + si; \
        const bf16_t* _zq = Z + (size_t)MROWS * C_QR + _zo; const bf16_t* _zk = Z + (size_t)MROWS * C_KR + _zo; const bf16_t* _zv = Z + (size_t)MROWS * C_VR + _zo; \
        q1 = *(const u32x4*)(_zq + sd0); q2 = *(const u32x4*)(_zq + 64 + sd0); \
        k1 = *(const u32x4*)(_zk + sd0); k2 = *(const u32x4*)(_zk + 64 + sd0); \
        v1 = *(const u32x4*)(_zv + sd0); v2 = *(const u32x4*)(_zv + 64 + sd0); \
        c0 = *(const f32x4*)(tcs + _trow * 64 + sd0); c1 = *(const f32x4*)(tcs + _trow * 64 + sd0 + 4); \
        s0 = *(const f32x4*)(tsn + _trow * 64 + sd0); s1 = *(const f32x4*)(tsn + _trow * 64 + sd0 + 4); \
        const bf16_t* _gp = Z + zrow_p(C_GR, 4, 128, _h, _b, (size_t)_c * 64 + gi) + gdv0; \
        gn1 = *(const u32x4*)_gp; gn2 = *(const u32x4*)(_gp + 8); \
        const float* _gw = p.gn_w + _h * 128 + gdv0; \
        gwn0 = *(const f32x4*)_gw; gwn1 = *(const f32x4*)(_gw + 4); gwn2 = *(const f32x4*)(_gw + 8); gwn3 = *(const f32x4*)(_gw + 12); \
        if (_c > 0) { const u32x2* _src = (const u32x2*)(p.ws + WS_SC) + ((size_t)(_b * 4 + _h) * 32 + (_c - 1)) * 4096 + (size_t)w * 512 + lane; \
            _Pragma("unroll") for (int f = 0; f < 8; ++f) sfr[f] = _src[f * 64]; } \
        else { _Pragma("unroll") for (int f = 0; f < 8; ++f) sfr[f] = (u32x2){0u, 0u}; } } while (0)
    const int bx = blockIdx.x;
    const bool rebal = (G == 256);
    int it = (rebal && bx < 16) ? bx + 4 * G : bx;
    int extra = (rebal && bx >= 16 && bx < 80) ? ((bx - 16) >> 2) + ((bx - 16) & 3) * G : -1;
    bool tail = false;
    if (it < 2048) OUT_LOAD(it);
    for (; it < 2048; ) {
        const int b = it >> 7, h = (it >> 5) & 3, c = it & 31;
        int nit = tail ? 2048 : it + G; bool ntail = tail;
        if (!tail && nit >= 2048 && extra >= 0) { nit = extra; ntail = true; }
        const float lg = __logf(1.0f - exp2f(-5.0f - (float)h));
        const float qd = __expf(lg * (float)(si + 1)), kd = __expf(-lg * (float)(si + 1)) * 0.08838834764831845f;
        {
            float qa[8], qb[8], ka[8], kb[8];
#pragma unroll
            for (int e = 0; e < 4; ++e) {
                const unsigned wq1 = q1[e], wq2 = q2[e], wk1 = k1[e], wk2 = k2[e];
#pragma unroll
                for (int hf = 0; hf < 2; ++hf) {
                    const int ee = e * 2 + hf;
                    const float cs = ee < 4 ? c0[ee & 3] : c1[ee & 3], sn = ee < 4 ? s0[ee & 3] : s1[ee & 3];
                    const float x1 = hf ? bf_hi(wq1) : bf_lo(wq1), x2 = hf ? bf_hi(wq2) : bf_lo(wq2);
                    const float y1 = hf ? bf_hi(wk1) : bf_lo(wk1), y2 = hf ? bf_hi(wk2) : bf_lo(wk2);
                    qa[ee] = (x1 * cs - x2 * sn) * qd; qb[ee] = (x2 * cs + x1 * sn) * qd;
                    ka[ee] = (y1 * cs - y2 * sn) * kd; kb[ee] = (y2 * cs + y1 * sn) * kd;
                }
            }
            *(u32x4*)(Qs + si * LDQ + sd0) = pack8(qa); *(u32x4*)(Qs + si * LDQ + 64 + sd0) = pack8(qb);
            *(u32x4*)(Ks + si * LDQ + sd0) = pack8(ka); *(u32x4*)(Ks + si * LDQ + 64 + sd0) = pack8(kb);
#pragma unroll
            for (int e = 0; e < 4; ++e) {
                Vt[(sd0 + 2 * e) * LDT + sc] = (bf16_t)(v1[e] & 0xffffu); Vt[(sd0 + 2 * e + 1) * LDT + sc] = (bf16_t)(v1[e] >> 16);
                Vt[(64 + sd0 + 2 * e) * LDT + sc] = (bf16_t)(v2[e] & 0xffffu); Vt[(64 + sd0 + 2 * e + 1) * LDT + sc] = (bf16_t)(v2[e] >> 16);
            }
#pragma unroll
            for (int t2 = 0; t2 < 2; ++t2)
#pragma unroll
                for (int g4 = 0; g4 < 4; ++g4) { const int dk0 = (kt0 + t2) * 32 + 8 * g4 + 4 * hh, dv = ct * 32 + l31; *(u32x2*)(St + dv * LDQ + dk0) = sfr[t2 * 4 + g4]; }
        }
        const u32x4 gc1 = gn1, gc2 = gn2; const f32x4 gw0 = gwn0, gw1 = gwn1, gw2 = gwn2, gw3 = gwn3;
        if (nit < 2048) OUT_LOAD(nit);
        asm volatile("" ::: "memory"); __builtin_amdgcn_sched_barrier(0);
        lds_barrier();
#pragma unroll
        for (int tq = 0; tq < 2; ++tq) {
            const int tt = w + tq * 8, jt = tt >> 2, itl = tt & 3;
            f32x4 a4 = {0.f, 0.f, 0.f, 0.f};
            if (itl >= jt) {
#pragma unroll
                for (int kk = 0; kk < 4; ++kk) {
                    const bf16x8 af = *(const bf16x8*)(Ks + (jt * 16 + (lane & 15)) * LDQ + kk * 32 + (lane >> 4) * 8);
                    const bf16x8 bfr = *(const bf16x8*)(Qs + (itl * 16 + (lane & 15)) * LDQ + kk * 32 + (lane >> 4) * 8);
                    a4 = mfma16(af, bfr, a4);
                }
            }
            const int i = itl * 16 + (lane & 15), j0 = jt * 16 + 4 * (lane >> 4);
            u32x2 wv; wv.x = cvt_pk(i >= j0 ? a4[0] : 0.f, i >= j0 + 1 ? a4[1] : 0.f); wv.y = cvt_pk(i >= j0 + 2 ? a4[2] : 0.f, i >= j0 + 3 ? a4[3] : 0.f);
            *(u32x2*)(As + i * LDA + j0) = wv;
        }
        lds_barrier();
        {
            f32x16 O;
#pragma unroll
            for (int r = 0; r < 16; ++r) O[r] = 0.f;
#pragma unroll
            for (int ks = 0; ks < 4; ++ks) {
                const bf16x8 vfr = *(const bf16x8*)(Vt + (ct * 32 + l31) * LDT + ((ks * 16 + 8 * hh + 8 * (((ct * 32 + l31) >> 3) & 7)) & 63));
                const bf16x8 af = *(const bf16x8*)(As + (rt * 32 + l31) * LDA + ks * 16 + 8 * hh);
                O = mfma32(af, vfr, O);
            }
#pragma unroll
            for (int ks = 0; ks < 8; ++ks) {
                const bf16x8 af = *(const bf16x8*)(Qs + (rt * 32 + l31) * LDQ + ks * 16 + 8 * hh);
                const bf16x8 bfr = *(const bf16x8*)(St + (ct * 32 + l31) * LDQ + ks * 16 + 8 * hh);
                O = mfma32(af, bfr, O);
            }
#pragma unroll
            for (int r = 0; r < 16; ++r) { const int i = rt * 32 + (r & 3) + 8 * (r >> 2) + 4 * hh; Ob[i * LDO + ct * 32 + l31] = O[r]; }
        }
        lds_barrier();
        {
            float o[16];
#pragma unroll
            for (int e4 = 0; e4 < 4; ++e4) { const f32x4 v = *(const f32x4*)(Ob + gi * LDO + gdv0 + e4 * 4); o[e4 * 4] = v[0]; o[e4 * 4 + 1] = v[1]; o[e4 * 4 + 2] = v[2]; o[e4 * 4 + 3] = v[3]; }
            float sm = 0.f;
#pragma unroll
            for (int e = 0; e < 16; ++e) sm += o[e];
            sm += __shfl_xor(sm, 1); sm += __shfl_xor(sm, 2); sm += __shfl_xor(sm, 4);
            const float mu = sm * (1.0f / 128.0f);
            float q = 0.f;
#pragma unroll
            for (int e = 0; e < 16; ++e) { const float d = o[e] - mu; q += d * d; }
            q += __shfl_xor(q, 1); q += __shfl_xor(q, 2); q += __shfl_xor(q, 4);
            const float rstd = rsqrtf(q * (1.0f / 128.0f) + 1e-5f);
            float r8[16];
#pragma unroll
            for (int e = 0; e < 8; ++e) {
                const unsigned wg = e < 4 ? gc1[e & 3] : gc2[e & 3];
                const float ga0 = e < 2 ? gw0[(2 * e) & 3] : e < 4 ? gw1[(2 * e) & 3] : e < 6 ? gw2[(2 * e) & 3] : gw3[(2 * e) & 3];
                const float ga1 = e < 2 ? gw0[(2 * e + 1) & 3] : e < 4 ? gw1[(2 * e + 1) & 3] : e < 6 ? gw2[(2 * e + 1) & 3] : gw3[(2 * e + 1) & 3];
                r8[2 * e] = (o[2 * e] - mu) * rstd * ga0 * silu_f(bf_lo(wg));
                r8[2 * e + 1] = (o[2 * e + 1] - mu) * rstd * ga1 * silu_f(bf_hi(wg));
            }
            bf16_t* mp = MX + ((size_t)b * 2048 + (size_t)c * 64 + gi) * DM + 512 + h * 128 + gdv0;
            *(u32x4*)mp = pack8(r8); *(u32x4*)(mp + 8) = pack8(r8 + 8);
        }
        it = nit; tail = ntail;
    }
#undef OUT_LOAD
    lds_barrier();
}

constexpr int W_KS = 0, W_VT = 36864;
constexpr int LDK = 72, LDV = 264;

template <bool SAMPLE>
__device__ __forceinline__ void swa_item(const Params& p, unsigned char* lds, int b, int blk, int kvh) {
    bf16_t* Ksw = (bf16_t*)(lds + W_KS); bf16_t* Vtw = (bf16_t*)(lds + W_VT);
    const bf16_t* Z = (const bf16_t*)(p.ws + WS_Z);
    bf16_t* MX = (bf16_t*)(p.ws + WS_MIX);
    const int tid = opaque_tid(), w = tid >> 6, lane = tid & 63, l31 = lane & 31, hh = lane >> 5;
    constexpr int NKEYS = SAMPLE ? 160 : 256;
    constexpr int NT = SAMPLE ? 1 : 2;
    bf16x8 Qf[4];
#define SWA_LOADQ(q2v) do { \
        const int _i0 = SAMPLE ? 0 : ((w & 1) * 2 + (q2v)) * 32; \
        const size_t _qrow = SAMPLE ? (size_t)NPROMPT + (size_t)b * 8 + (l31 & 7) : (size_t)b * 2048 + blk * 128 + _i0 + l31; \
        const int _head = SAMPLE ? kvh * 4 + (l31 >> 3) : kvh * 4 + (w >> 1); \
        _Pragma("unroll") for (int ks = 0; ks < 4; ++ks) Qf[ks] = *(const bf16x8*)(Z + (SAMPLE ? zrow_s(C_QA, 8, 64, _head, b, l31 & 7) : zrow_p(C_QA, 8, 64, _head, b, (size_t)blk * 128 + _i0 + l31)) + ks * 16 + 8 * hh); } while (0)
    SWA_LOADQ(0);
    for (int idx = tid; idx < NKEYS * 8; idx += 512) {
        const int j = idx >> 3, d0 = (idx & 7) * 8;
        u32x4 kq = {0u, 0u, 0u, 0u}, vq = {0u, 0u, 0u, 0u};
        if (!SAMPLE) {
            const int tk = blk * 128 - 128 + j;
            if (tk >= 0) { const size_t zo = zrow_p(0, 2, 64, kvh, b, tk) + d0; kq = *(const u32x4*)(Z + (size_t)MROWS * C_KA + zo); vq = *(const u32x4*)(Z + (size_t)MROWS * C_VA + zo); }
        } else {
            if (j < 128) {
                const float* ckp = p.ck + (((size_t)b * 128 + j) * 2 + kvh) * 64 + d0; const float* cvp = p.cv + (((size_t)b * 128 + j) * 2 + kvh) * 64 + d0;
                const f32x4 a0 = *(const f32x4*)ckp, a1 = *(const f32x4*)(ckp + 4), b0 = *(const f32x4*)cvp, b1 = *(const f32x4*)(cvp + 4);
                kq.x = cvt_pk(a0[0], a0[1]); kq.y = cvt_pk(a0[2], a0[3]); kq.z = cvt_pk(a1[0], a1[1]); kq.w = cvt_pk(a1[2], a1[3]);
                vq.x = cvt_pk(b0[0], b0[1]); vq.y = cvt_pk(b0[2], b0[3]); vq.z = cvt_pk(b1[0], b1[1]); vq.w = cvt_pk(b1[2], b1[3]);
            } else if (j < 136) {
                const size_t zo = zrow_s(0, 2, 64, kvh, b, j - 128) + d0; kq = *(const u32x4*)(Z + (size_t)MROWS * C_KA + zo); vq = *(const u32x4*)(Z + (size_t)MROWS * C_VA + zo);
            }
        }
        *(u32x4*)(Ksw + j * LDK + d0) = kq;
        const int kk = j & 15, jp = (((j & ~15) | (((kk >> 2) & 1) << 3) | (((kk >> 3) & 1) << 2) | (kk & 3)) + d0) & 255;
#pragma unroll
        for (int e = 0; e < 4; ++e) { Vtw[(d0 + 2 * e) * LDV + jp] = (bf16_t)(vq[e] & 0xffffu); Vtw[(d0 + 2 * e + 1) * LDV + jp] = (bf16_t)(vq[e] >> 16); }
    }
    lds_barrier();
    if (!SAMPLE || w == 0) {
        const int g = w >> 1;
#pragma unroll 1
        for (int q2 = 0; q2 < NT; ++q2) {

            const int i0 = SAMPLE ? 0 : ((w & 1) * 2 + q2) * 32;
                        const int head = SAMPLE ? kvh * 4 + (l31 >> 3) : kvh * 4 + g;
            const int iq = SAMPLE ? (l31 & 7) : i0 + l31;
            const float sink = p.sinks[head];
            f32x16 S[5];
#pragma unroll
            for (int kt = 0; kt < 5; ++kt) {
#pragma unroll
                for (int r = 0; r < 16; ++r) S[kt][r] = 0.f;
#pragma unroll
                for (int ks = 0; ks < 4; ++ks) { const bf16x8 kf = *(const bf16x8*)(Ksw + (i0 + 32 * kt + l31) * LDK + ks * 16 + 8 * hh); S[kt] = mfma32(kf, Qf[ks], S[kt]); }
            }
            if (q2 + 1 < NT) SWA_LOADQ(q2 + 1);
            float m = sink;
#pragma unroll
            for (int kt = 0; kt < 5; ++kt)
#pragma unroll
                for (int r = 0; r < 16; ++r) {
                    const int j = i0 + 32 * kt + (r & 3) + 8 * (r >> 2) + 4 * hh;
                    const bool valid = (j >= iq) && (j <= iq + 128) && (SAMPLE || blk > 0 || j >= 128);
                    const float s = valid ? S[kt][r] * 0.125f : -1e30f;
                    S[kt][r] = s; m = fmaxf(m, s);
                }
            m = fmaxf(m, __shfl_xor(m, 32));
            float sum = 0.f;
#pragma unroll
            for (int kt = 0; kt < 5; ++kt)
#pragma unroll
                for (int r = 0; r < 16; ++r) { const float e = __expf(S[kt][r] - m); S[kt][r] = e; sum += e; }
            sum += __shfl_xor(sum, 32);
            const float inv = 1.0f / (sum + __expf(sink - m));
            bf16_t graw[2][16];
#pragma unroll
            for (int dt = 0; dt < 2; ++dt)
#pragma unroll
                for (int r = 0; r < 16; ++r) {
                    const int qc = (r & 3) + 8 * (r >> 2) + 4 * hh;
                    const size_t orow = SAMPLE ? (size_t)NPROMPT + (size_t)b * 8 + (qc & 7) : (size_t)b * 2048 + blk * 128 + i0 + qc;
                    graw[dt][r] = Z[(SAMPLE ? zrow_s(C_GA, 8, 64, kvh * 4, b, 0) : zrow_p(C_GA, 8, 64, kvh * 4 + g, b, (size_t)blk * 128 + i0)) + qc * 64 + dt * 32 + l31];
                }
            f32x16 O[2];
#pragma unroll
            for (int dt = 0; dt < 2; ++dt)
#pragma unroll
                for (int r = 0; r < 16; ++r) O[dt][r] = 0.f;
#pragma unroll
            for (int kt = 0; kt < 5; ++kt)
#pragma unroll
                for (int s2 = 0; s2 < 2; ++s2) {
                    u32x4 pw;
                    pw.x = cvt_pk(S[kt][8 * s2 + 0] * inv, S[kt][8 * s2 + 1] * inv); pw.y = cvt_pk(S[kt][8 * s2 + 2] * inv, S[kt][8 * s2 + 3] * inv);
                    pw.z = cvt_pk(S[kt][8 * s2 + 4] * inv, S[kt][8 * s2 + 5] * inv); pw.w = cvt_pk(S[kt][8 * s2 + 6] * inv, S[kt][8 * s2 + 7] * inv);
#pragma unroll
                    for (int dt = 0; dt < 2; ++dt) { const bf16x8 vfr = *(const bf16x8*)(Vtw + (dt * 32 + l31) * LDV + ((i0 + 32 * kt + 16 * s2 + 8 * hh + 8 * (((dt * 32 + l31) >> 3) & 7)) & 255)); O[dt] = mfma32(as_frag(pw), vfr, O[dt]); }
                }
#pragma unroll
            for (int dt = 0; dt < 2; ++dt)
#pragma unroll
                for (int r = 0; r < 16; ++r) {
                    const int qc = (r & 3) + 8 * (r >> 2) + 4 * hh;
                    const size_t orow = SAMPLE ? (size_t)NPROMPT + (size_t)b * 8 + (qc & 7) : (size_t)b * 2048 + blk * 128 + i0 + qc;
                    const int col = (SAMPLE ? kvh * 4 + (qc >> 3) : kvh * 4 + g) * 64 + dt * 32 + l31;
                    const float gv = __uint_as_float(((unsigned)graw[dt][r]) << 16);
                    MX[orow * DM + col] = (bf16_t)(cvt_pk(O[dt][r] * silu_f(gv), 0.f) & 0xffffu);
                }
        }
    }
    lds_barrier();
#undef SWA_LOADQ
}

__device__ __forceinline__ void p2a_mixers(const Params& p, unsigned char* lds) {
    const int G = gridDim.x, bx = blockIdx.x;
    const int NRET = 64;
    if (G > NRET) {
        if (bx < NRET) { ret_chain(p, lds, bx >> 2, bx & 3); return; }
    } else {
        for (int it = bx; it < NRET; it += G) ret_chain(p, lds, it >> 2, it & 3);
    }
    const int nb = G > NRET ? G - NRET : G, me = G > NRET ? bx - NRET : bx;
    for (int it = me; it < 512 + 512 + 256; it += nb) {
        if (it < 512) { swa_item<false>(p, lds, it >> 5, (it >> 1) & 15, it & 1); }
        else if (it < 1024) { const int s = it - 512; ret_item<true>(p, lds, s >> 2, s & 3); }
        else { const int s = it - 1024; swa_item<true>(p, lds, s >> 1, 0, s & 1); }
    }
}

struct OneUnit {
    int pm, pn;
    __device__ bool next(int i, pg8::Unit& u) const { if (i != 0) return false; u.pm = pm; u.pn = pn; return true; }
    __device__ __forceinline__ void a_ready(const pg8::Unit&) const {}
    __device__ __forceinline__ void done(const pg8::Unit&) const {}
};
__global__ void __launch_bounds__(512) hymba_fwd(Params p) {
    extern __shared__ __attribute__((aligned(16))) unsigned char lds[];
    cg::grid_group grid = cg::this_grid();
    unsigned* bar = (unsigned*)(p.ws + WS_BAR);
    if (blockIdx.x == 0 && threadIdx.x == 0) __hip_atomic_store(bar, 0u, __ATOMIC_RELAXED, __HIP_MEMORY_SCOPE_AGENT);
    p0_prologue(p, lds);
    grid.sync();
    p1a_modulate(p);
    fast_grid_barrier(bar, 1u);
    {
        pg8::Gemm g{(const pg8::bf16_t*)(p.ws + WS_H), (const pg8::bf16_t*)(p.ws + WS_WIN), MROWS, DIN, DM};
        pg8::StaticOrder S; S.init(MROWS, DIN, (int)gridDim.x, (int)blockIdx.x);
        EpiZ E{(bf16_t*)(p.ws + WS_Z), p.out};
        pg8::gemm_phase<EpiZ, pg8::StaticOrder>((PG8_LAS unsigned char*)lds, g, S, E);
    }
    fast_grid_barrier(bar, 2u);
    p2a_mixers(p, lds);
    fast_grid_barrier(bar, 3u);
    if (gridDim.x == 256 && blockIdx.x < 16) {
        pg8::Gemm g{(const pg8::bf16_t*)(p.ws + WS_MIX), (const pg8::bf16_t*)(p.ws + WS_WOUT), MROWS, DM, DM};
        OneUnit S{128 + ((int)blockIdx.x >> 2), (int)blockIdx.x & 3};
        EpiY E{(bf16_t*)(p.ws + WS_Y)};
        pg8::gemm_phase<EpiY, OneUnit>((PG8_LAS unsigned char*)lds, g, S, E);
    }
    p2b_ret_out(p, lds);
    fast_grid_barrier(bar, 4u);
    {
        const int mrows = gridDim.x == 256 ? NPROMPT : MROWS;
        pg8::Gemm g{(const pg8::bf16_t*)(p.ws + WS_MIX), (const pg8::bf16_t*)(p.ws + WS_WOUT), mrows, DM, DM};
        pg8::StaticOrder S; S.init(mrows, DM, (int)gridDim.x, (int)blockIdx.x);
        EpiY E{(bf16_t*)(p.ws + WS_Y)};
        pg8::gemm_phase<EpiY, pg8::StaticOrder>((PG8_LAS unsigned char*)lds, g, S, E);
    }
    fast_grid_barrier(bar, 5u);
    p4_layernorm(p);
}

extern "C" void kernel_launch(void* const* d_in, const int* in_sizes, int n_in, void* d_out, int out_size, void* d_ws, size_t ws_size, hipStream_t stream) {
    static int grid_blocks = 0;
    if (!grid_blocks) {
        int dev = 0, cus = 0, per_cu = 0;
        hipGetDevice(&dev);
        hipDeviceGetAttribute(&cus, hipDeviceAttributeMultiprocessorCount, dev);
        hipFuncSetAttribute((const void*)hymba_fwd, hipFuncAttributeMaxDynamicSharedMemorySize, LDS_BYTES);
        hipOccupancyMaxActiveBlocksPerMultiprocessor(&per_cu, (const void*)hymba_fwd, 512, LDS_BYTES);
        if (per_cu < 1) { fprintf(stderr, "kernel_launch: occupancy query reports %d blocks per CU\n", per_cu); per_cu = 1; }
        grid_blocks = cus * per_cu;
        if (grid_blocks > 256) grid_blocks = 256;
    }
    Params p{};
    p.xp = (const float*)d_in[0]; p.xs = (const float*)d_in[1]; p.cp = (const float*)d_in[2]; p.cs = (const float*)d_in[3];
    p.ck = (const float*)d_in[4]; p.cv = (const float*)d_in[5]; p.st = (const float*)d_in[6];
    p.w_ada = (const float*)d_in[7]; p.b_ada = (const float*)d_in[8]; p.w_in = (const float*)d_in[9]; p.sinks = (const float*)d_in[10];
    p.gn_w = (const float*)d_in[11]; p.w_out = (const float*)d_in[12]; p.ln_w = (const float*)d_in[13]; p.ln_b = (const float*)d_in[14];
    p.out = (float*)d_out; p.ws = (unsigned char*)d_ws;
    void* args[] = {&p};
    hipError_t e = hipLaunchCooperativeKernel((const void*)hymba_fwd, dim3(grid_blocks), dim3(512), args, LDS_BYTES, stream);
    if (e != hipSuccess) fprintf(stderr, "cooperative launch failed: %s (grid %d)\n", hipGetErrorString(e), grid_blocks);
}
```
